# Optimizing an MI355X kernel written in HIP

```python
import math
import jax, jax.numpy as jnp
from jax import lax
import numpy as np

D_MODEL = 1024
BATCH = 8
SEQ = 4096
DEPTH = 4

N_META = 16
N_MIXERS = 2
N_ATTN_LAYERS = (DEPTH + 1) // 2
N_GLA_LAYERS = DEPTH // 2
DA_HEADS = 8
DA_HEAD_DIM = D_MODEL // DA_HEADS // 2
DA_V_DIM = 2 * DA_HEAD_DIM
Q_BLOCK = 128
GLA_HEADS = 4
GLA_KEY_DIM = D_MODEL // 2
GLA_VAL_DIM = D_MODEL
GLA_HK = GLA_KEY_DIM // GLA_HEADS
GLA_HV = GLA_VAL_DIM // GLA_HEADS
GLA_GATE_RANK = 16
GLA_GATE_NORM = 16.0
GLA_CHUNK = 64
GLA_IN_DIM = 2 * GLA_KEY_DIM + 2 * GLA_VAL_DIM + GLA_GATE_RANK
D_FF = 4 * D_MODEL
EPS = 1e-6

kernel_name = "hybrid_diffattn_gla_sqrelu"


def rmsnorm(x, w):
    xf = x.astype(jnp.float32)
    y = xf * lax.rsqrt(jnp.mean(xf * xf, axis=-1, keepdims=True) + EPS)
    return (y * w.astype(jnp.float32)).astype(x.dtype)


def lambda_init_for(layer_idx):
    return 0.8 - 0.6 * math.exp(-0.3 * layer_idx)


def alibi_slopes(n_heads):
    return 2.0 ** (-8.0 * jnp.arange(1, n_heads + 1, dtype=jnp.float32) / n_heads)


def diff_attention(x, w_in, lam_params, subln_w, w_out, lambda_init):
    B, L, _ = x.shape
    q, k, v = jnp.split(x @ w_in, [D_MODEL, 2 * D_MODEL], axis=-1)
    q = q.reshape(B, L, DA_HEADS, 2, DA_HEAD_DIM)
    k = k.reshape(B, L, DA_HEADS, 2, DA_HEAD_DIM)
    v = v.reshape(B, L, DA_HEADS, DA_V_DIM)
    lp = lam_params.astype(jnp.float32)
    lam = jnp.exp(jnp.sum(lp[0] * lp[1])) - jnp.exp(jnp.sum(lp[2] * lp[3])) + lambda_init
    slopes = alibi_slopes(DA_HEADS)[None, :, None, None, None]
    scale = DA_HEAD_DIM ** -0.5
    bounds = [(0, N_META)] + [(s, min(s + Q_BLOCK, L)) for s in range(N_META, L, Q_BLOCK)]
    outs = []
    for s, e in bounds:
        qb = q[:, s:e]
        kb = k[:, :e]
        vb = v[:, :e]
        scores = jnp.einsum('bqhcd,bkhcd->bhcqk', qb, kb).astype(jnp.float32) * scale
        dist = (jnp.arange(s, e)[:, None] - jnp.arange(e)[None, :]).astype(jnp.float32)
        scores = jnp.where(dist >= 0.0, scores - slopes * dist, -jnp.inf)
        p = jax.nn.softmax(scores, axis=-1)
        attn = p[:, :, 0] - lam * p[:, :, 1]
        outs.append(jnp.einsum('bhqk,bkhe->bqhe', attn.astype(vb.dtype), vb))
    o = jnp.concatenate(outs, axis=1)
    o = rmsnorm(o, subln_w) * (1.0 - lambda_init)
    return o.reshape(B, L, DA_HEADS * DA_V_DIM) @ w_out


def gla_chunk(S, q, k, v, glog):
    C = q.shape[2]
    b = jnp.cumsum(glog, axis=2)
    causal = jnp.tril(jnp.ones((C, C), dtype=bool))
    diff = b[:, :, :, None, :] - b[:, :, None, :, :]
    decay = jnp.exp(jnp.where(causal[:, :, None], diff, -jnp.inf))
    a = jnp.einsum('bhid,bhjd,bhijd->bhij', q, k, decay)
    o = jnp.einsum('bhij,bhje->bhie', a, v) + jnp.einsum('bhid,bhde->bhie', q * jnp.exp(b), S)
    b_last = b[:, :, -1:, :]
    S = jnp.exp(b_last[:, :, 0, :, None]) * S + jnp.einsum('bhjd,bhje->bhde', k * jnp.exp(b_last - b), v)
    return S, o


def gla(x, w_in, w_gate_up, gate_bias, norm_w, w_out):
    B, L, _ = x.shape
    splits = [GLA_KEY_DIM, 2 * GLA_KEY_DIM, 2 * GLA_KEY_DIM + GLA_VAL_DIM, 2 * GLA_KEY_DIM + 2 * GLA_VAL_DIM]
    q, k, v, g, gz = jnp.split(x @ w_in, splits, axis=-1)
    glog = jax.nn.log_sigmoid((gz @ w_gate_up + gate_bias).astype(jnp.float32)) / GLA_GATE_NORM

    def heads(t, d):
        return t.reshape(B, L, GLA_HEADS, d).transpose(0, 2, 1, 3).astype(jnp.float32)

    q = heads(q, GLA_HK) * (GLA_HK ** -0.5)
    k = heads(k, GLA_HK)
    v = heads(v, GLA_HV)
    glog = heads(glog, GLA_HK)
    S0 = jnp.zeros((B, GLA_HEADS, GLA_HK, GLA_HV), jnp.float32)
    S, o_meta = gla_chunk(S0, q[:, :, :N_META], k[:, :, :N_META], v[:, :, :N_META], glog[:, :, :N_META])
    n_real = L - N_META
    n_chunks = n_real // GLA_CHUNK

    def to_chunks(t):
        t = t[:, :, N_META:]
        return t.reshape(B, GLA_HEADS, n_chunks, GLA_CHUNK, t.shape[-1]).transpose(2, 0, 1, 3, 4)

    def step(state, inp):
        return gla_chunk(state, *inp)

    _, o_real = lax.scan(step, S, (to_chunks(q), to_chunks(k), to_chunks(v), to_chunks(glog)))
    o_real = o_real.transpose(1, 2, 0, 3, 4).reshape(B, GLA_HEADS, n_real, GLA_HV)
    o = jnp.concatenate([o_meta, o_real], axis=2).transpose(0, 2, 1, 3)
    o = rmsnorm(o, norm_w) * jax.nn.silu(g.reshape(B, L, GLA_HEADS, GLA_HV).astype(jnp.float32))
    return o.reshape(B, L, GLA_VAL_DIM).astype(x.dtype) @ w_out


def sq_relu_mlp(x, w_up, w_down):
    return jnp.square(jax.nn.relu(x @ w_up)) @ w_down


def setup_inputs(seed: int = 0) -> dict:
    key = jax.random.key(seed)
    ks = jax.random.split(key, 17)

    def nrm(k, shape, scale):
        return jax.random.normal(k, shape, jnp.float32) * scale

    return {
        "x": nrm(ks[0], (BATCH, SEQ, D_MODEL), 1.0),
        "meta_tokens": nrm(ks[1], (N_META, D_MODEL), 1.0),
        "mix_norm_w": 1.0 + nrm(ks[2], (DEPTH, D_MODEL), 0.02),
        "attn_w_in": nrm(ks[3], (N_ATTN_LAYERS, D_MODEL, 3 * D_MODEL), D_MODEL ** -0.5),
        "attn_lambda": nrm(ks[4], (N_ATTN_LAYERS, 4, DA_HEAD_DIM), 0.1),
        "attn_subln_w": 1.0 + nrm(ks[5], (N_ATTN_LAYERS, DA_V_DIM), 0.02),
        "attn_w_out": nrm(ks[6], (N_ATTN_LAYERS, DA_HEADS * DA_V_DIM, D_MODEL), (DA_HEADS * DA_V_DIM) ** -0.5),
        "gla_w_in": nrm(ks[7], (N_GLA_LAYERS, D_MODEL, GLA_IN_DIM), D_MODEL ** -0.5),
        "gla_w_gate_up": nrm(ks[8], (N_GLA_LAYERS, GLA_GATE_RANK, GLA_KEY_DIM), GLA_GATE_RANK ** -0.5),
        "gla_gate_bias": nrm(ks[9], (N_GLA_LAYERS, GLA_KEY_DIM), 0.02),
        "gla_norm_w": 1.0 + nrm(ks[10], (N_GLA_LAYERS, GLA_HV), 0.02),
        "gla_w_out": nrm(ks[11], (N_GLA_LAYERS, GLA_VAL_DIM, D_MODEL), GLA_VAL_DIM ** -0.5),
        "mlp_norm_w": 1.0 + nrm(ks[12], (DEPTH, D_MODEL), 0.02),
        "mlp_w_up": nrm(ks[13], (DEPTH, D_MODEL, D_FF), D_MODEL ** -0.5),
        "mlp_w_down": nrm(ks[14], (DEPTH, D_FF, D_MODEL), D_FF ** -0.5),
        "final_norm_w": 1.0 + nrm(ks[15], (D_MODEL,), 0.02),
    }


def reference(x, meta_tokens, mix_norm_w, attn_w_in, attn_lambda, attn_subln_w, attn_w_out,
              gla_w_in, gla_w_gate_up, gla_gate_bias, gla_norm_w, gla_w_out,
              mlp_norm_w, mlp_w_up, mlp_w_down, final_norm_w):
    B = x.shape[0]
    meta = jnp.broadcast_to(meta_tokens[None].astype(x.dtype), (B, N_META, D_MODEL))
    h = jnp.concatenate([meta, x], axis=1)
    for i in range(DEPTH):
        hn = rmsnorm(h, mix_norm_w[i])
        j = i // N_MIXERS
        if i % N_MIXERS == 0:
            h = h + diff_attention(hn, attn_w_in[j], attn_lambda[j], attn_subln_w[j], attn_w_out[j],
                                   lambda_init_for(i))
        else:
            h = h + gla(hn, gla_w_in[j], gla_w_gate_up[j], gla_gate_bias[j], gla_norm_w[j], gla_w_out[j])
        h = h + sq_relu_mlp(rmsnorm(h, mlp_norm_w[i]), mlp_w_up[i], mlp_w_down[i])
    return rmsnorm(h[:, N_META:], final_norm_w)
```

```cpp
#include <hip/hip_runtime.h>
#include <hip/hip_cooperative_groups.h>
#include <cstdio>
#include <cstdint>
#include <cmath>
namespace cg = cooperative_groups;
__device__ __forceinline__ int opaque_tid() { int t = threadIdx.x; asm volatile("" : "+v"(t)); return t; }
namespace pg8 {
#define PG8_LAS __attribute__((address_space(3)))
typedef unsigned short bf16_t;
typedef short bf16x8 __attribute__((ext_vector_type(8)));
typedef float f32x4 __attribute__((ext_vector_type(4)));
typedef unsigned u32x4 __attribute__((ext_vector_type(4)));
constexpr int BM = 256, BK = 64, HALF = 128, HTB = HALF * BK * 2  , STAGE_BYTES = 8 * HTB, NXCD = 8, WGM = 8;

__host__ __device__ __forceinline__ int lds_byte(int r, int c) { const int st = (r >> 4) * 2 + (c >> 5), rr = r & 15, cc = c & 31, ob = rr * 64 + cc * 2; return st * 1024 + (ob ^ (((ob >> 9) & 1) << 5)); }
__host__ __device__ __forceinline__ void stage_rc(int b, int& R, int& C) { const int st = b / 1024, sb = b % 1024, swz = sb ^ (((sb >> 9) & 1) << 5); R = (st >> 1) * 16 + swz / 64; C = (st & 1) * 32 + (swz % 64) / 2; }
__host__ __device__ __forceinline__ int perm32(int rho) { const int n = rho >> 4, i = rho & 15; return 8 * (i >> 2) + 4 * n + (i & 3); }

struct Unit { int pm, pn; };
struct Gemm { const bf16_t* A; const bf16_t* Bt; int M, N, K; };

struct StaticOrder {
    int nM, nN, nwg, G, c;
    __host__ __device__ void init(int M, int N, int G_, int c_) { nM = M / BM; nN = N / BM; nwg = nM * nN; G = G_; c = c_; }
    __host__ __device__ bool next(int i, Unit& u) const {
        const long L = (long)i * G + c; if (L >= nwg) return false;
        int wgid = (int)L; { const int q = nwg / NXCD, r = nwg % NXCD, xcd = wgid % NXCD, off = wgid / NXCD; wgid = (xcd < r ? xcd * (q + 1) : r * (q + 1) + (xcd - r) * q) + off; }
        const int nig = WGM * nN, gid = wgid / nig, fm = gid * WGM, gsz = (nM - fm) < WGM ? (nM - fm) : WGM;
        u.pm = fm + ((wgid % nig) % gsz); u.pn = (wgid % nig) / gsz; return true;
    }
    __device__ __forceinline__ void a_ready(const Unit&) const {}
    __device__ __forceinline__ void done(const Unit&) const {}
};

__device__ __forceinline__ unsigned cvt_pk_bf16(float lo, float hi) { unsigned r; asm volatile("v_cvt_pk_bf16_f32 %0, %1, %2" : "=v"(r) : "v"(lo), "v"(hi)); return r; }
typedef float f32x2 __attribute__((ext_vector_type(2)));
typedef unsigned u32x2 __attribute__((ext_vector_type(2)));
enum { EM_ATT_QK = 0, EM_ATT_VT = 1, EM_RELU2 = 2, EM_GLA_QKG = 3, EM_GLA_VT = 4 };
struct EpiB {
    static constexpr bool PERM = true, AFTER_DRAIN = false;
    int mode; bf16_t* p0; bf16_t* p1; float scale0;
    __device__ __forceinline__ void operator()(const f32x4 (&acc)[2][2][4][2], const Unit& u, int wr, int wc, int fr, int fq) const {
        const int row0 = u.pm * BM + wr * 64 + fr; const int colt = u.pn * BM; const int cl = wc * 32 + 8 * fq;
        float sc = 1.f; if (mode == EM_ATT_QK && colt < 1024) sc = scale0;
#pragma unroll
        for (int ai = 0; ai < 2; ++ai)
#pragma unroll
            for (int m = 0; m < 4; ++m) {
                const int row = row0 + ai * HALF + m * 16;
#pragma unroll
                for (int bj = 0; bj < 2; ++bj) {
                    const int col = colt + cl + bj * HALF;
                    f32x4 v0 = acc[ai][bj][m][0], v1 = acc[ai][bj][m][1];
                    bf16_t* dst;
                    if (mode == EM_ATT_QK) {
                        if (colt < 1024) dst = p0 + (size_t)row * 1024 + col;
                        else { const int kc = col - 1024, h = kc >> 7, ch = (kc & 127) >> 3, b = row >> 12, t = row & 4095;
                               dst = p1 + ((((size_t)(b * 8 + h) * 64 + (t >> 6)) * 16 + ch) * 64 + (t & 63)) * 8; }
                    } else if (mode == EM_ATT_VT) {
                        const int h = row >> 7, d = row & 127, b = col >> 12, t = col & 4095;
                        dst = p0 + ((((size_t)(b * 8 + h) * 64 + (t >> 6)) * 8 + ((t & 63) >> 3)) * 128 + d) * 8;
                    } else if (mode == EM_RELU2) {
                        v0 = __builtin_elementwise_max(v0, (f32x4){0.f, 0.f, 0.f, 0.f}); v1 = __builtin_elementwise_max(v1, (f32x4){0.f, 0.f, 0.f, 0.f});
                        v0 = v0 * v0; v1 = v1 * v1;
                        dst = p0 + (size_t)row * 4096 + col;
                    } else if (mode == EM_GLA_QKG) {
                        dst = (colt < 1024) ? p0 + (size_t)row * 1024 + col : p1 + (size_t)row * 1024 + (col - 1024);
                    } else {
                        const int h = row >> 8, dv = row & 255, b = col >> 12, t = col & 4095;
                        dst = p0 + ((((size_t)(b * 4 + h) * 64 + (t >> 6)) * 8 + ((t & 63) >> 3)) * 256 + dv) * 8;
                    }
                    v0 = v0 * sc; v1 = v1 * sc;
                    u32x4 w; w.x = cvt_pk_bf16(v0[0], v0[1]); w.y = cvt_pk_bf16(v0[2], v0[3]); w.z = cvt_pk_bf16(v1[0], v1[1]); w.w = cvt_pk_bf16(v1[2], v1[3]);
                    *(u32x4*)dst = w;
                }
            }
    }
};
struct EpiRes {
    static constexpr bool PERM = false, AFTER_DRAIN = false;
    const float* base; float* out;
    __device__ __forceinline__ void operator()(const f32x4 (&acc)[2][2][4][2], const Unit& u, int wr, int wc, int fr, int fq) const {
        const int row0 = u.pm * BM + wr * 64 + fr; const int col0 = u.pn * BM + wc * 32 + 4 * fq;
#pragma unroll
        for (int ai = 0; ai < 2; ++ai) {
            f32x4 bs[4][2][2];
#pragma unroll
            for (int m = 0; m < 4; ++m) { const size_t off = (size_t)(row0 + ai * HALF + m * 16) * 1024 + col0;
#pragma unroll
                for (int bj = 0; bj < 2; ++bj)
#pragma unroll
                    for (int n = 0; n < 2; ++n) bs[m][bj][n] = *(const f32x4*)(base + off + bj * HALF + n * 16); }
#pragma unroll
            for (int m = 0; m < 4; ++m) { const size_t off = (size_t)(row0 + ai * HALF + m * 16) * 1024 + col0;
#pragma unroll
                for (int bj = 0; bj < 2; ++bj)
#pragma unroll
                    for (int n = 0; n < 2; ++n) *(f32x4*)(out + off + bj * HALF + n * 16) = bs[m][bj][n] + acc[ai][bj][m][n]; }
        }
    }
};
template <class Epi, class Sched, bool ALIGN_EPI = false, bool SP2 = false>
__device__ __forceinline__ void gemm_phase(PG8_LAS unsigned char* lds, const Gemm g, const Sched& S, const Epi& E) {
    const int tid = opaque_tid(), wid = __builtin_amdgcn_readfirstlane(tid >> 6), lane = tid & 63, wr = wid >> 2, wc = wid & 3, fr = lane & 15, fq = lane >> 4;
    const int K = g.K, nt = K / BK;
    unsigned voffA[2], voffB[2];
#pragma unroll
    for (int i = 0; i < 2; ++i) { int R, C; stage_rc(tid * 16 + i * 8192, R, C); const int Rb = Epi::PERM ? ((R & ~31) + perm32(R & 31)) : R;
        voffA[i] = (unsigned)(R * K + C) * 2u; voffB[i] = (unsigned)(Rb * K + C) * 2u; }
    const size_t kstep = (size_t)(BK * 2);
    const size_t hstep = (size_t)HALF * K * 2;
    const size_t tstep = 2 * hstep;
    const unsigned ldsw = (unsigned)wid * 1024u;
    const int aoff = lds_byte(wr * 64 + fr, fq * 8), boff = lds_byte(wc * 32 + fr, fq * 8);
#define PG8_SA(b, h) (((b) * 2 + (h)) * HTB)
#define PG8_SB(b, h) ((4 + (b) * 2 + (h)) * HTB)
#define PG8_STAGE(bufoff, gbase, voff) do { _Pragma("unroll") for (int _i = 0; _i < 2; ++_i) \
        __builtin_amdgcn_global_load_lds((const unsigned*)((const char*)(gbase) + (voff)[_i]), (PG8_LAS unsigned*)(lds + (bufoff) + ldsw + _i * 8192), 16, 0, 0); } while (0)
#define PG8_LDA(dst, b, h) do { _Pragma("unroll") for (int m = 0; m < 4; ++m) _Pragma("unroll") for (int k = 0; k < 2; ++k) dst[m][k] = *(const PG8_LAS bf16x8*)(lds + PG8_SA(b, h) + aoff + m * 2048 + k * 1024); } while (0)
#define PG8_LDB(dst, b, h) do { _Pragma("unroll") for (int n = 0; n < 2; ++n) _Pragma("unroll") for (int k = 0; k < 2; ++k) dst[n][k] = *(const PG8_LAS bf16x8*)(lds + PG8_SB(b, h) + boff + n * 2048 + k * 1024); } while (0)
#define PG8_MMA(ai, bj, At, Bt) do { __builtin_amdgcn_s_setprio(1); _Pragma("unroll") for (int m = 0; m < 4; ++m) _Pragma("unroll") for (int n = 0; n < 2; ++n) _Pragma("unroll") for (int k = 0; k < 2; ++k) \
        acc[ai][bj][m][n] = __builtin_amdgcn_mfma_f32_16x16x32_bf16(Bt[n][k], At[m][k], acc[ai][bj][m][n], 0, 0, 0); __builtin_amdgcn_s_setprio(0); } while (0)
#define PG8_WAIT_V(n) asm volatile("s_waitcnt vmcnt(" #n ")" ::: "memory")
#define PG8_WAIT_L(n) asm volatile("s_waitcnt lgkmcnt(" #n ")" ::: "memory")
#define PG8_BAR __builtin_amdgcn_s_barrier()
#define PG8_SCHED __builtin_amdgcn_sched_barrier(0)
    Unit cur, nxt; int ui = 0;
    if (!S.next(0, cur)) return;
    f32x4 acc[2][2][4][2];
#pragma unroll
    for (int a = 0; a < 2; ++a)
#pragma unroll
        for (int b = 0; b < 2; ++b)
#pragma unroll
            for (int m = 0; m < 4; ++m)
#pragma unroll
                for (int n = 0; n < 2; ++n) acc[a][b][m][n] = (f32x4){0.f, 0.f, 0.f, 0.f};
    bf16x8 At[4][2], B0[2][2], B1[2][2];
    const char* cA = (const char*)g.A + (size_t)cur.pm * tstep; const char* cB = (const char*)g.Bt + (size_t)cur.pn * tstep;
    S.a_ready(cur);
    if constexpr (SP2) {
        PG8_STAGE(PG8_SB(0, 0), cB, voffB); PG8_STAGE(PG8_SB(0, 1), cB + hstep, voffB); PG8_STAGE(PG8_SA(0, 0), cA, voffA); PG8_STAGE(PG8_SA(0, 1), cA + hstep, voffA);
        if (wr == 1) PG8_BAR;
        PG8_WAIT_V(2); PG8_BAR;
        PG8_STAGE(PG8_SB(1, 0), cB + kstep, voffB); PG8_STAGE(PG8_SA(1, 0), cA + kstep, voffA); PG8_STAGE(PG8_SB(1, 1), cB + hstep + kstep, voffB);
        PG8_WAIT_V(6); PG8_BAR;
    } else {
        PG8_STAGE(PG8_SB(0, 0), cB, voffB); PG8_STAGE(PG8_SA(0, 0), cA, voffA); PG8_STAGE(PG8_SB(0, 1), cB + hstep, voffB); PG8_STAGE(PG8_SA(0, 1), cA + hstep, voffA);
        if (wr == 1) PG8_BAR;
        PG8_WAIT_V(4); PG8_BAR;
        PG8_STAGE(PG8_SB(1, 0), cB + kstep, voffB); PG8_STAGE(PG8_SA(1, 0), cA + kstep, voffA); PG8_STAGE(PG8_SB(1, 1), cB + hstep + kstep, voffB);
        PG8_WAIT_V(6); PG8_BAR;
    }
    for (;;) {
        const bool has_next = S.next(ui + 1, nxt);
        const char* nA = has_next ? (const char*)g.A + (size_t)nxt.pm * tstep : cA; const char* nB = has_next ? (const char*)g.Bt + (size_t)nxt.pn * tstep : cB;
        for (int t = 0; t < nt; t += 2) {
            const bool last = (t == nt - 2);
            const char* a1 = cA + (size_t)(t + 1) * kstep;
            const char* a2 = last ? nA : cA + (size_t)(t + 2) * kstep; const char* b2 = last ? nB : cB + (size_t)(t + 2) * kstep;
            const char* a3 = a2 + kstep; const char* b3 = b2 + kstep;
            if (last && has_next) S.a_ready(nxt);
            if constexpr (SP2) {
            PG8_LDB(B0, 0, 0); PG8_LDB(B1, 0, 1); PG8_SCHED; PG8_LDA(At, 0, 0); PG8_STAGE(PG8_SA(1, 1), a1 + hstep, voffA);
            PG8_WAIT_V(8); PG8_WAIT_L(0); PG8_BAR; PG8_MMA(0, 0, At, B0); PG8_MMA(0, 1, At, B1); PG8_BAR; PG8_SCHED;
            PG8_LDA(At, 0, 1); PG8_STAGE(PG8_SB(0, 0), b2, voffB); PG8_STAGE(PG8_SB(0, 1), b2 + hstep, voffB); PG8_STAGE(PG8_SA(0, 0), a2, voffA);
            PG8_WAIT_V(8); PG8_WAIT_L(0); PG8_BAR; PG8_MMA(1, 0, At, B0); PG8_MMA(1, 1, At, B1); PG8_BAR; PG8_SCHED;
            PG8_LDB(B0, 1, 0); PG8_LDB(B1, 1, 1); PG8_SCHED; PG8_LDA(At, 1, 0); PG8_STAGE(PG8_SA(0, 1), a2 + hstep, voffA);
            PG8_WAIT_V(8); PG8_WAIT_L(0); PG8_BAR; PG8_MMA(0, 0, At, B0); PG8_MMA(0, 1, At, B1); PG8_BAR; PG8_SCHED;
            PG8_LDA(At, 1, 1); PG8_STAGE(PG8_SB(1, 0), b3, voffB); PG8_STAGE(PG8_SB(1, 1), b3 + hstep, voffB); PG8_STAGE(PG8_SA(1, 0), a3, voffA);
            PG8_WAIT_V(8); PG8_WAIT_L(0); PG8_BAR; PG8_MMA(1, 0, At, B0); PG8_MMA(1, 1, At, B1); PG8_BAR; PG8_SCHED;
            } else {
            PG8_LDB(B0, 0, 0); PG8_SCHED; PG8_LDA(At, 0, 0); PG8_STAGE(PG8_SA(1, 1), a1 + hstep, voffA);
            PG8_WAIT_L(8); PG8_BAR; PG8_WAIT_L(0); PG8_MMA(0, 0, At, B0); PG8_BAR; PG8_SCHED;
            PG8_LDB(B1, 0, 1); PG8_STAGE(PG8_SB(0, 0), b2, voffB);
            PG8_BAR; PG8_WAIT_L(0); PG8_MMA(0, 1, At, B1); PG8_BAR;
            PG8_LDA(At, 0, 1); PG8_STAGE(PG8_SA(0, 0), a2, voffA);
            PG8_BAR; PG8_WAIT_L(0); PG8_MMA(1, 0, At, B0); PG8_BAR; PG8_SCHED;
            PG8_STAGE(PG8_SB(0, 1), b2 + hstep, voffB);
            PG8_WAIT_V(6); PG8_BAR; PG8_MMA(1, 1, At, B1); PG8_BAR;
            PG8_LDB(B0, 1, 0); PG8_SCHED; PG8_LDA(At, 1, 0); PG8_STAGE(PG8_SA(0, 1), a2 + hstep, voffA);
            PG8_WAIT_L(8); PG8_BAR; PG8_WAIT_L(0); PG8_MMA(0, 0, At, B0); PG8_BAR; PG8_SCHED;
            PG8_LDB(B1, 1, 1); PG8_STAGE(PG8_SB(1, 0), b3, voffB);
            PG8_BAR; PG8_WAIT_L(0); PG8_MMA(0, 1, At, B1); PG8_BAR;
            PG8_LDA(At, 1, 1); PG8_STAGE(PG8_SA(1, 0), a3, voffA);
            PG8_BAR; PG8_WAIT_L(0); PG8_MMA(1, 0, At, B0); PG8_BAR; PG8_SCHED;
            PG8_STAGE(PG8_SB(1, 1), b3 + hstep, voffB);
            PG8_WAIT_V(6); PG8_BAR; PG8_MMA(1, 1, At, B1); PG8_BAR;
            }
        }
        if constexpr (ALIGN_EPI) { if (wr == 0) PG8_BAR; }
        if constexpr (!Epi::AFTER_DRAIN) { E(acc, cur, wr, wc, fr, fq); S.done(cur); }
        if (!has_next) break;
#pragma unroll
        for (int a = 0; a < 2; ++a)
#pragma unroll
            for (int b = 0; b < 2; ++b)
#pragma unroll
                for (int m = 0; m < 4; ++m)
#pragma unroll
                    for (int n = 0; n < 2; ++n) acc[a][b][m][n] = (f32x4){0.f, 0.f, 0.f, 0.f};
        cur = nxt; cA = nA; cB = nB; ++ui;
        if constexpr (ALIGN_EPI) { if (wr == 1) PG8_BAR; }
    }
    PG8_WAIT_V(0);
    if constexpr (!ALIGN_EPI) { if (wr == 0) PG8_BAR; }
    PG8_BAR;
    if constexpr (Epi::AFTER_DRAIN) { E.fused(acc, cur, wr, wc, fr, fq, lds, wid, lane); S.done(cur); }
#undef PG8_SA
#undef PG8_SB
#undef PG8_STAGE
#undef PG8_LDA
#undef PG8_LDB
#undef PG8_MMA
#undef PG8_WAIT_V
#undef PG8_WAIT_L
#undef PG8_BAR
#undef PG8_SCHED
}
}

#define LAS __attribute__((address_space(3)))
typedef unsigned short bf16_t;
typedef short bf16x8 __attribute__((ext_vector_type(8)));
typedef float f32x4 __attribute__((ext_vector_type(4)));
typedef float f32x16 __attribute__((ext_vector_type(16)));
typedef unsigned u32x4 __attribute__((ext_vector_type(4)));
typedef unsigned u32x2 __attribute__((ext_vector_type(2)));

constexpr int NWAVES = 8, NTHR = 512;
constexpr int DM = 1024, NB = 8, SEQ = 4096, MR = NB * SEQ  , NMETA = 16, MT = MR + NMETA, FF = 4096;
constexpr float EPS = 1e-6f;
constexpr float LOG2E = 1.4426950408889634f;
constexpr float QSCALE = 0.125f * LOG2E;
constexpr int LDS_BAR_OFF = 153600;
constexpr int LDS_BYTES = 153856;

constexpr size_t MiB = 1u << 20;
constexpr size_t WS_CTL = 0;
constexpr size_t WS_WQKV = 1 * MiB, WS_WQKV_STRIDE = 6 * MiB;
constexpr size_t WS_WAO = 13 * MiB, WS_WAO_STRIDE = 2 * MiB;
constexpr size_t WS_WGLA = 17 * MiB, WS_WGLA_STRIDE = 7 * MiB;
constexpr size_t WS_WGO = 31 * MiB, WS_WGO_STRIDE = 2 * MiB;
constexpr size_t WS_WUP = 35 * MiB, WS_WUP_STRIDE = 8 * MiB;
constexpr size_t WS_WDN = 67 * MiB, WS_WDN_STRIDE = 8 * MiB;
constexpr size_t WS_HMETA = 99 * MiB;
constexpr size_t WS_HN = 100 * MiB;
constexpr size_t WS_BIG = 166 * MiB;
constexpr size_t AB_Q = WS_BIG, AB_KIMG = WS_BIG + 65 * MiB, AB_VIMG = WS_BIG + 129 * MiB, AB_KMETA = WS_BIG + 193 * MiB, AB_VMETA = AB_KMETA + 131072;
constexpr size_t KiB64 = 65536;
constexpr size_t GB_QK = WS_BIG, GB_G = GB_QK + 1025 * KiB64, GB_VT = GB_G + 1025 * KiB64, GB_VTMETA = GB_VT + 1024 * KiB64, GB_GZ = GB_VTMETA + 2 * KiB64,
                 GB_QP = GB_GZ + 33 * KiB64, GB_KT = GB_QP + 514 * KiB64, GB_A = GB_KT + 514 * KiB64, GB_DEC = GB_A + 257 * KiB64, GB_ORAW = GB_DEC + 33 * KiB64,
                 GB_END = GB_ORAW + 1027 * KiB64;
constexpr size_t MB_U = WS_BIG;
constexpr size_t WS_END = GB_END;
static_assert(GB_END <= 512 * MiB && MB_U + (size_t)MT * FF * 2 <= GB_END && AB_VMETA + 131072 <= GB_END, "workspace map");

__device__ __forceinline__ float wave_sum(float v) {
#pragma unroll
    for (int o = 1; o < 64; o <<= 1) v += __shfl_xor(v, o);
    return v;
}
typedef float f32x2_t __attribute__((ext_vector_type(2))); typedef __bf16 bf16x2_t __attribute__((ext_vector_type(2)));
__device__ __forceinline__ unsigned pk_bf16(float lo, float hi) { f32x2_t v = {lo, hi}; bf16x2_t b = __builtin_convertvector(v, bf16x2_t); return __builtin_bit_cast(unsigned, b); }
__device__ __forceinline__ float bf2f(bf16_t v) { return __uint_as_float((unsigned)v << 16); }
__device__ __forceinline__ bf16_t f2bf(float f) { return (bf16_t)(pk_bf16(f, 0.f) & 0xffffu); }
__device__ __forceinline__ float fexp2(float x) { return __builtin_amdgcn_exp2f(x); }

__device__ __forceinline__ void p0_transpose_item(const float* W, int ldw, int K, bf16_t* WT, int k0, int n0, int orow0, LAS float* scr, int lane) {
#pragma unroll 8
    for (int i = 0; i < 32; ++i) { const int kk = 2 * i + (lane >> 5); scr[kk * 33 + (lane & 31)] = W[(size_t)(k0 + kk) * ldw + n0 + (lane & 31)]; }
    asm volatile("s_waitcnt lgkmcnt(0)" ::: "memory");
    const int c = lane & 7;
#pragma unroll
    for (int j = 0; j < 4; ++j) { const int n = (lane >> 3) + 8 * j; const LAS float* s = scr + (8 * c) * 33 + n;
        u32x4 o; o.x = pk_bf16(s[0 * 33], s[1 * 33]); o.y = pk_bf16(s[2 * 33], s[3 * 33]); o.z = pk_bf16(s[4 * 33], s[5 * 33]); o.w = pk_bf16(s[6 * 33], s[7 * 33]);
        *(u32x4*)(WT + (size_t)(orow0 + n) * K + k0 + 8 * c) = o; }
    asm volatile("s_waitcnt lgkmcnt(0)" ::: "memory");
}

struct Ptrs {
    const float *x, *meta, *mix_w, *attn_w_in, *attn_lam, *attn_subln, *attn_w_out, *gla_w_in, *gla_w_gate, *gla_bias, *gla_norm, *gla_w_out, *mlp_norm, *mlp_up, *mlp_dn, *final_w;
    float* out; unsigned char* ws;
};

typedef const __attribute__((address_space(4))) Ptrs* KP;
__device__ __forceinline__ void p0_prologue(KP P, LAS unsigned char* lds, int G) {
    const int tid = opaque_tid(), lane = tid & 63, wid = __builtin_amdgcn_readfirstlane(tid >> 6);
    LAS float* scr = (LAS float*)(lds + wid * 16384);
    const int gw = blockIdx.x * NWAVES + wid, NGW = G * NWAVES;
    constexpr int I_AIN = 16 * 96, I_AO = 16 * 32, I_GIN = 16 * 96, I_GO = 16 * 32, I_UP = 16 * 128, I_DN = 64 * 32;
    constexpr int NITEMS = 2 * I_AIN + 2 * I_AO + 2 * I_GIN + 2 * I_GO + 4 * I_UP + 4 * I_DN;
    for (int it = gw; it < NITEMS; it += NGW) {
        int r = it;
        if (r < 2 * I_AIN) { const int j = r / I_AIN; r -= j * I_AIN; const int kb = r / 96, nb = r % 96;
            p0_transpose_item(P->attn_w_in + (size_t)j * 1024 * 3072, 3072, 1024, (bf16_t*)(P->ws + WS_WQKV + j * WS_WQKV_STRIDE), 64 * kb, 32 * nb, 32 * nb, scr, lane); continue; }
        r -= 2 * I_AIN;
        if (r < 2 * I_AO) { const int j = r / I_AO; r -= j * I_AO; const int kb = r / 32, nb = r % 32;
            p0_transpose_item(P->attn_w_out + (size_t)j * 1024 * 1024, 1024, 1024, (bf16_t*)(P->ws + WS_WAO + j * WS_WAO_STRIDE), 64 * kb, 32 * nb, 32 * nb, scr, lane); continue; }
        r -= 2 * I_AO;
        if (r < 2 * I_GIN) { const int j = r / I_GIN; r -= j * I_GIN; const int kb = r / 96, nb = r % 96; const int n0 = 32 * nb;
            const int orow = n0 < 1024 ? n0 : (n0 < 2048 ? n0 + 1024 : n0 - 1024);
            p0_transpose_item(P->gla_w_in + (size_t)j * 1024 * 3088, 3088, 1024, (bf16_t*)(P->ws + WS_WGLA + j * WS_WGLA_STRIDE), 64 * kb, n0, orow, scr, lane); continue; }
        r -= 2 * I_GIN;
        if (r < 2 * I_GO) { const int j = r / I_GO; r -= j * I_GO; const int kb = r / 32, nb = r % 32;
            p0_transpose_item(P->gla_w_out + (size_t)j * 1024 * 1024, 1024, 1024, (bf16_t*)(P->ws + WS_WGO + j * WS_WGO_STRIDE), 64 * kb, 32 * nb, 32 * nb, scr, lane); continue; }
        r -= 2 * I_GO;
        if (r < 4 * I_UP) { const int j = r / I_UP; r -= j * I_UP; const int kb = r / 128, nb = r % 128;
            p0_transpose_item(P->mlp_up + (size_t)j * 1024 * 4096, 4096, 1024, (bf16_t*)(P->ws + WS_WUP + j * WS_WUP_STRIDE), 64 * kb, 32 * nb, 32 * nb, scr, lane); continue; }
        r -= 4 * I_UP;
        { const int j = r / I_DN; r -= j * I_DN; const int kb = r / 32, nb = r % 32;
            p0_transpose_item(P->mlp_dn + (size_t)j * 4096 * 1024, 1024, 4096, (bf16_t*)(P->ws + WS_WDN + j * WS_WDN_STRIDE), 64 * kb, 32 * nb, 32 * nb, scr, lane); }
    }
    const int gt = blockIdx.x * NTHR + tid, NGT = G * NTHR;
    for (int e = gt; e < 2 * 16 * 1024; e += NGT) { const int j = e >> 14, rr = (e >> 10) & 15, k = e & 1023;
        ((bf16_t*)(P->ws + WS_WGLA + j * WS_WGLA_STRIDE))[(size_t)(3072 + rr) * 1024 + k] = f2bf(P->gla_w_in[(size_t)j * 1024 * 3088 + (size_t)k * 3088 + 3072 + rr]); }
}

__device__ __forceinline__ void norm_phase(const float* src_real, const float* src_meta, const float* w, bf16_t* hn, int G) {
    const int tid = opaque_tid(), lane = tid & 63, wid = __builtin_amdgcn_readfirstlane(tid >> 6);
    const int gw = blockIdx.x * NWAVES + wid, NGW = G * NWAVES;
    f32x4 wv[4];
#pragma unroll
    for (int j = 0; j < 4; ++j) wv[j] = ((const f32x4*)w)[lane + 64 * j];
    for (int row = gw; row < MT; row += NGW) {
        const float* xr = row < MR ? src_real + (size_t)row * DM : src_meta + (size_t)(row - MR) * DM;
        f32x4 v[4]; float s = 0.f;
#pragma unroll
        for (int j = 0; j < 4; ++j) { v[j] = ((const f32x4*)xr)[lane + 64 * j]; s += (v[j].x * v[j].x + v[j].y * v[j].y) + (v[j].z * v[j].z + v[j].w * v[j].w); }
        const float r = rsqrtf(wave_sum(s) * (1.f / DM) + EPS);
        u32x2* o8 = (u32x2*)(hn + (size_t)row * DM) + lane;
#pragma unroll
        for (int j = 0; j < 4; ++j) { u32x2 o; o.x = pk_bf16(v[j].x * r * wv[j].x, v[j].y * r * wv[j].y); o.y = pk_bf16(v[j].z * r * wv[j].z, v[j].w * r * wv[j].w); o8[64 * j] = o; }
    }
}
__device__ __forceinline__ void final_norm_phase(float* h, const float* w, int G) {
    const int tid = opaque_tid(), lane = tid & 63, wid = __builtin_amdgcn_readfirstlane(tid >> 6);
    const int gw = blockIdx.x * NWAVES + wid, NGW = G * NWAVES;
    f32x4 wv[4];
#pragma unroll
    for (int j = 0; j < 4; ++j) wv[j] = ((const f32x4*)w)[lane + 64 * j];
    for (int row = gw; row < MR; row += NGW) {
        f32x4* xr = (f32x4*)(h + (size_t)row * DM);
        f32x4 v[4]; float s = 0.f;
#pragma unroll
        for (int j = 0; j < 4; ++j) { v[j] = xr[lane + 64 * j]; s += (v[j].x * v[j].x + v[j].y * v[j].y) + (v[j].z * v[j].z + v[j].w * v[j].w); }
        const float r = rsqrtf(wave_sum(s) * (1.f / DM) + EPS);
#pragma unroll
        for (int j = 0; j < 4; ++j) xr[lane + 64 * j] = v[j] * r * wv[j];
    }
}

enum { MM_ATT = 0, MM_RES = 1, MM_RELU2 = 2, MM_GLA = 3, MM_GZ = 4 };
struct MiniEpi { int mode; void* p0; void* p1; void* p2; const float* base; };
__device__ __forceinline__ void mini_store(const MiniEpi& E, int row, int n, float v) {
    if (E.mode == MM_ATT) {
        if (n < 1024) ((bf16_t*)E.p0)[(size_t)(MR + row) * 1024 + n] = f2bf(v * QSCALE);
        else if (n < 2048) { const int kc = n - 1024, h = kc >> 7, ch = (kc & 127) >> 3; ((bf16_t*)E.p1)[((size_t)(h * 16 + ch) * 64 + row) * 8 + (kc & 7)] = f2bf(v); }
        else { const int vc = n - 2048, h = vc >> 7, d = vc & 127; ((bf16_t*)E.p2)[((size_t)(h * 8 + (row >> 3)) * 128 + d) * 8 + (row & 7)] = f2bf(v); }
    } else if (E.mode == MM_RES) {
        ((float*)E.p0)[(size_t)row * 1024 + n] = E.base[(size_t)row * 1024 + n] + v;
    } else if (E.mode == MM_RELU2) {
        const float r = fmaxf(v, 0.f); ((bf16_t*)E.p0)[(size_t)(MR + row) * 4096 + n] = f2bf(r * r);
    } else if (E.mode == MM_GLA) {
        if (n < 1024) ((bf16_t*)E.p0)[(size_t)(MR + row) * 1024 + n] = f2bf(v);
        else if (n < 2048) ((bf16_t*)E.p1)[(size_t)(MR + row) * 1024 + (n - 1024)] = f2bf(v);
        else { const int vc = n - 2048, h = vc >> 8, dv = vc & 255; ((bf16_t*)E.p2)[((size_t)(h * 8 + (row >> 3)) * 256 + dv) * 8 + (row & 7)] = f2bf(v); }
    } else {
        ((float*)E.p0)[(size_t)n * 16 + row] = v;
    }
}
__device__ __forceinline__ void mini_gemm(LAS unsigned char* lds, const bf16_t* A16, const bf16_t* Bt, int N, int K, const MiniEpi& E, int G) {
    const int tid = opaque_tid(), lane = tid & 63, wid = __builtin_amdgcn_readfirstlane(tid >> 6);
    LAS float* part = (LAS float*)lds;
    const int kw = K / 8, k0 = wid * kw;
    for (int task = blockIdx.x; task < N / 16; task += G) {
        const bf16_t* ap = A16 + (size_t)(lane & 15) * K + k0 + (lane >> 4) * 8;
        const bf16_t* bp = Bt + (size_t)(task * 16 + (lane & 15)) * K + k0 + (lane >> 4) * 8;
        f32x4 acc = {0.f, 0.f, 0.f, 0.f};
#pragma unroll 4
        for (int k = 0; k < kw; k += 32) { const bf16x8 a = *(const bf16x8*)(ap + k); const bf16x8 b = *(const bf16x8*)(bp + k); acc = __builtin_amdgcn_mfma_f32_16x16x32_bf16(a, b, acc, 0, 0, 0); }
#pragma unroll
        for (int j = 0; j < 4; ++j) part[wid * 256 + ((lane >> 4) * 4 + j) * 16 + (lane & 15)] = acc[j];
        __syncthreads();
        if (tid < 256) { float s = 0.f;
#pragma unroll
            for (int w = 0; w < 8; ++w) s += part[w * 256 + tid];
            mini_store(E, tid >> 4, task * 16 + (tid & 15), s); }
        __syncthreads();
    }
}

__device__ __forceinline__ void gz_gemm(const bf16_t* Wz  , const bf16_t* hn  , float* gz, int G) {
    const int tid = opaque_tid(), lane = tid & 63, wid = __builtin_amdgcn_readfirstlane(tid >> 6);
    for (int task = blockIdx.x * NWAVES + wid; task < MT / 16; task += G * NWAVES) {
        const bf16_t* ap = Wz + (size_t)(lane & 15) * DM + (lane >> 4) * 8;
        const bf16_t* bp = hn + (size_t)(task * 16 + (lane & 15)) * DM + (lane >> 4) * 8;
        f32x4 acc0 = {0.f, 0.f, 0.f, 0.f}, acc1 = {0.f, 0.f, 0.f, 0.f};
#pragma unroll 8
        for (int k = 0; k < DM; k += 64) {
            const bf16x8 a0 = *(const bf16x8*)(ap + k), b0 = *(const bf16x8*)(bp + k), a1 = *(const bf16x8*)(ap + k + 32), b1 = *(const bf16x8*)(bp + k + 32);
            acc0 = __builtin_amdgcn_mfma_f32_16x16x32_bf16(a0, b0, acc0, 0, 0, 0); acc1 = __builtin_amdgcn_mfma_f32_16x16x32_bf16(a1, b1, acc1, 0, 0, 0); }
        const f32x4 r = acc0 + acc1;
        *(f32x4*)(gz + (size_t)(task * 16 + (lane & 15)) * 16 + (lane >> 4) * 4) = r;
    }
}

__device__ __forceinline__ void glds16(const void* gsrc, unsigned lds_dst) { unsigned keep;
    asm volatile("s_mov_b32 %0, m0\n\ts_mov_b32 m0, %2\n\ts_nop 0\n\tglobal_load_lds_dwordx4 %1, off\n\ts_mov_b32 m0, %0" : "=&s"(keep) : "v"(gsrc), "s"(lds_dst) : "memory"); }
__device__ __forceinline__ float max3f(float a, float b, float c) { float r; asm("v_max3_f32 %0, %1, %2, %3" : "=v"(r) : "v"(a), "v"(b), "v"(c)); return r; }
#define WAITV_BAR(N) asm volatile("s_waitcnt vmcnt(" #N ") lgkmcnt(0)\n\ts_barrier" ::: "memory")
__device__ __forceinline__ float half_max(float v) { const unsigned u = __float_as_uint(v); auto rr = __builtin_amdgcn_permlane32_swap(u, u, false, false);
    return fmaxf(__uint_as_float(rr[0]), __uint_as_float(rr[1])); }
__device__ __forceinline__ int kvperm(int i) { const int r = 4 * (i >> 3) + (i & 3), hh = (i >> 2) & 1; return 16 * (r >> 3) + 8 * hh + (r & 7); }

__device__ __forceinline__ void attn_phase(LAS unsigned char* lds, const bf16_t* Q, const bf16_t* Kimg, const bf16_t* Vimg, const bf16_t* Kmeta, const bf16_t* Vmeta,
                                           bf16_t* O, const float* lamp, const float* sublnw, float lambda_init, int G) {
    const int tid = opaque_tid(), lane = tid & 63, wid = __builtin_amdgcn_readfirstlane(tid >> 6), l31 = lane & 31, hi = lane >> 5;
    const int qg = wid & 3, c = wid >> 2;
    const int skew = (wid ^ (wid >> 2)) & 1;
    float lam;
    { const float a = lamp[lane] * lamp[64 + lane], b2 = lamp[128 + lane] * lamp[192 + lane]; lam = __expf(wave_sum(a)) - __expf(wave_sum(b2)) + lambda_init; }
    const int kvrow = kvperm(l31);
    LAS float* exch = (LAS float*)(lds + qg * 16384);
    for (int item = blockIdx.x; item < 1024 + 8; item += G) {
        for (int half = 0; half < 2; ++half) {
            int b, h, qb; bool metaq = false;
            if (item < 1024) {
                int bh = item >> 4, s = item & 15;
                if (G == 256) {
                    const int v = item & 255, it = item >> 8, x = v & 7, t = v >> 3;
                    bh = (it >> 1) * 32 + x * 4 + (t >> 3); s = (t & 7) + 8 * (it & 1);
                }
                b = bh >> 3; h = bh & 7; qb = half ? 31 - s : s; }
            else { if (half) break; metaq = true; b = 0; h = item - 1024; qb = 0; }
            const int NT = metaq ? 1 : 2 * qb + 3;
            const bool active = !metaq || qg == 0;
            const int qpos0 = metaq ? 0 : 16 + 128 * qb;
            const int qrow = metaq ? MR + l31 : b * SEQ + 128 * qb + 32 * qg + l31;
            const int qpos = metaq ? l31 : qpos0 + 32 * qg + l31;
            const float slope2 = exp2f(-(float)(h + 1)) * LOG2E;
            const bf16_t* Kbh = Kimg + (size_t)(b * 8 + h) * 64 * 8192; const bf16_t* Vbh = Vimg + (size_t)(b * 8 + h) * 64 * 8192;
            const bf16_t* Kmh = Kmeta + (size_t)h * 8192; const bf16_t* Vmh = Vmeta + (size_t)h * 8192;
            const unsigned ldsb = (unsigned)(uintptr_t)lds;
#define ATT_DMA_K(j) do { const char* ks_ = (const char*)((j) == 0 ? Kmh : Kbh + (size_t)((j) - 1) * 8192); \
            _Pragma("unroll") for (int i_ = 0; i_ < 2; ++i_) glds16(ks_ + i_ * 8192 + wid * 1024 + lane * 16, (unsigned)__builtin_amdgcn_readfirstlane(ldsb + ((j) & 3) * 16384 + i_ * 8192 + wid * 1024)); } while (0)
#define ATT_DMA_V(j) do { const char* vs_ = (const char*)((j) == 0 ? Vmh : Vbh + (size_t)((j) - 1) * 8192); \
            _Pragma("unroll") for (int i_ = 0; i_ < 2; ++i_) glds16(vs_ + i_ * 8192 + wid * 1024 + lane * 16, (unsigned)__builtin_amdgcn_readfirstlane(ldsb + 65536 + ((j) & 3) * 16384 + i_ * 8192 + wid * 1024)); } while (0)
#define ATT_QK(SA, SB, j_) do { const int kp0_ = ((j_) == 0) ? 0 : 16 + 64 * ((j_) - 1); const float tb_ = slope2 * (float)(kp0_ - qpos0 + 8 * hi); \
            _Pragma("unroll") for (int r = 0; r < 16; ++r) { SA[r] = fmaf(slope2, (float)(16 * (r >> 3) + (r & 7)), tb_); SB[r] = fmaf(slope2, (float)(32 + 16 * (r >> 3) + (r & 7)), tb_); } \
            const LAS unsigned char* Kb_ = lds + ((j_) & 3) * 16384; \
            _Pragma("unroll") for (int d0 = 0; d0 < 4; ++d0) { const int chunk_ = c * 8 + 2 * d0 + hi; \
                const bf16x8 k0_ = *(const LAS bf16x8*)(Kb_ + chunk_ * 1024 + kvrow * 16); const bf16x8 k1_ = *(const LAS bf16x8*)(Kb_ + chunk_ * 1024 + (32 + kvrow) * 16); \
                SA = __builtin_amdgcn_mfma_f32_32x32x16_bf16(k0_, qf[d0], SA, 0, 0, 0); SB = __builtin_amdgcn_mfma_f32_32x32x16_bf16(k1_, qf[d0], SB, 0, 0, 0); } } while (0)
#define ATT_PV(PK, j_) do { const LAS unsigned char* Vb_ = ((j_) < 0) ? lds : lds + 65536 + ((j_) & 3) * 16384;     \
            _Pragma("unroll") for (int s4 = 0; s4 < 4; ++s4) { const bf16x8 pf_ = __builtin_bit_cast(bf16x8, PK[s4]); \
                _Pragma("unroll") for (int d = 0; d < 4; ++d) { const bf16x8 vf_ = *(const LAS bf16x8*)(Vb_ + (2 * s4 + hi) * 2048 + (32 * d + l31) * 16); \
                    o[d] = __builtin_amdgcn_mfma_f32_32x32x16_bf16(vf_, pf_, o[d], 0, 0, 0); } } } while (0)
            ATT_DMA_K(0); ATT_DMA_V(0);
            if (NT > 1) { ATT_DMA_K(1); ATT_DMA_V(1); }
            if (NT > 2) ATT_DMA_K(2);
            bf16x8 qf[4];
#pragma unroll
            for (int d0 = 0; d0 < 4; ++d0) qf[d0] = *(const bf16x8*)(Q + (size_t)qrow * 1024 + h * 128 + c * 64 + 16 * d0 + 8 * hi);
            f32x16 o[4];
#pragma unroll
            for (int d = 0; d < 4; ++d)
#pragma unroll
                for (int r = 0; r < 16; ++r) o[d][r] = 0.f;
            float mrun = -INFINITY, lrun = 0.f, alpha = 1.f;
            u32x4 pk[4];
#pragma unroll
            for (int s4 = 0; s4 < 4; ++s4) pk[s4] = (u32x4){0u, 0u, 0u, 0u};
            f32x16 sA, sB;
            asm volatile("" :: "v"(qf[0]), "v"(qf[1]), "v"(qf[2]), "v"(qf[3]));
            WAITV_BAR(0);
            if (active) ATT_QK(sA, sB, 0);
            for (int j = 0; j < NT; ++j) {
                if (j + 3 < NT) ATT_DMA_K(j + 3);
                if (j + 2 < NT) ATT_DMA_V(j + 2);
                if (active) {
                    if (j == 0 || j >= NT - 2) {
                        const int kpos0 = (j == 0) ? 0 : 16 + 64 * (j - 1);
                        const int lim = (j == 0) ? (metaq ? (l31 < 15 ? l31 : 15) : 15) : (qpos - kpos0);
#pragma unroll
                        for (int r = 0; r < 16; ++r) { const int kvl = 16 * (r >> 3) + (r & 7) + 8 * hi;
                            if (kvl > lim) sA[r] = -INFINITY; if (kvl + 32 > lim) sB[r] = -INFINITY; }
                    }
                    float mx = max3f(sA[0], sA[1], sA[2]);
#pragma unroll
                    for (int r = 3; r < 15; r += 2) mx = max3f(mx, sA[r], sA[r + 1]);
                    mx = max3f(mx, sA[15], sB[0]);
#pragma unroll
                    for (int r = 1; r < 15; r += 2) mx = max3f(mx, sB[r], sB[r + 1]);
                    mx = fmaxf(mx, sB[15]);
                    mx = half_max(mx);
                    alpha = 1.f;
                    if (__any(mx > mrun + 64.f)) { const float mnew_ = fmaxf(mrun, mx); alpha = fexp2(mrun - mnew_); mrun = mnew_; }
                    const float mnew = mrun;
                    float ps = 0.f;
#pragma unroll
                    for (int q4 = 0; q4 < 8; ++q4) {
                        const float a0 = fexp2(sA[2 * q4] - mnew), a1 = fexp2(sA[2 * q4 + 1] - mnew), b0 = fexp2(sB[2 * q4] - mnew), b1 = fexp2(sB[2 * q4 + 1] - mnew);
                        ps += (a0 + a1) + (b0 + b1);
                        pk[q4 >> 2][q4 & 3] = pk_bf16(a0, a1); pk[2 + (q4 >> 2)][q4 & 3] = pk_bf16(b0, b1); }
                    lrun = lrun * alpha + ps;
                }
                if (skew == 1) { if (j + 3 < NT) WAITV_BAR(4); else WAITV_BAR(0); }
                if (active) {
                    const LAS unsigned char* Vb = lds + 65536 + (j & 3) * 16384;
                    const LAS unsigned char* Kb = lds + ((j + 1) & 3) * 16384;
                    bf16x8 fa[4], fb[4];
#define VFR(F, s4) _Pragma("unroll") for (int i = 0; i < 4; ++i) F[i] = *(const LAS bf16x8*)(Vb + (2 * (s4) + hi) * 2048 + (32 * i + l31) * 16)
#define KFR(F, dh) _Pragma("unroll") for (int i = 0; i < 4; ++i) F[i] = *(const LAS bf16x8*)(Kb + (c * 8 + 2 * (2 * (dh) + (i >> 1)) + hi) * 1024 + (32 * (i & 1) + kvrow) * 16)
#define PVM(F, s4) _Pragma("unroll") for (int i = 0; i < 4; ++i) o[i] = __builtin_amdgcn_mfma_f32_32x32x16_bf16(F[i], __builtin_bit_cast(bf16x8, pk[s4]), o[i], 0, 0, 0)
#define QKM(F, dh) _Pragma("unroll") for (int i = 0; i < 2; ++i) { sA = __builtin_amdgcn_mfma_f32_32x32x16_bf16(F[2 * i], qf[2 * (dh) + i], sA, 0, 0, 0); sB = __builtin_amdgcn_mfma_f32_32x32x16_bf16(F[2 * i + 1], qf[2 * (dh) + i], sB, 0, 0, 0); }
#define SBAR __builtin_amdgcn_sched_barrier(0)
                    __builtin_amdgcn_s_setprio(1);
                    VFR(fa, 0);
                    if (__any(alpha != 1.f)) {
#pragma unroll
                        for (int d = 0; d < 4; ++d)
#pragma unroll
                            for (int r = 0; r < 16; ++r) o[d][r] *= alpha;
                    }
                    SBAR; VFR(fb, 1); SBAR; PVM(fa, 0); SBAR; VFR(fa, 2); SBAR; PVM(fb, 1); SBAR; VFR(fb, 3); SBAR; PVM(fa, 2); SBAR; KFR(fa, 0); SBAR; PVM(fb, 3); SBAR; KFR(fb, 1);
                    { const int kp0_ = 16 + 64 * j; const float tb_ = slope2 * (float)(kp0_ - qpos0 + 8 * hi);
#pragma unroll
                      for (int r = 0; r < 16; ++r) { sA[r] = fmaf(slope2, (float)(16 * (r >> 3) + (r & 7)), tb_); sB[r] = fmaf(slope2, (float)(32 + 16 * (r >> 3) + (r & 7)), tb_); } }
                    SBAR; QKM(fa, 0); SBAR; QKM(fb, 1);
                    __builtin_amdgcn_s_setprio(0);
#undef VFR
#undef KFR
#undef PVM
#undef QKM
#undef SBAR
                }
                if (skew == 0) { if (j + 3 < NT) WAITV_BAR(4); else WAITV_BAR(0); }
            }
            const float ltot = lrun + __shfl_xor(lrun, 32);
            const float inv = 1.f / ltot;
            if (c == 1 && active) {
#pragma unroll
                for (int d = 0; d < 4; ++d)
#pragma unroll
                    for (int r = 0; r < 16; ++r) exch[(d * 16 + r) * 64 + lane] = o[d][r] * inv;
            }
            __syncthreads();
            if (c == 0 && active) {
                float ss = 0.f;
#pragma unroll
                for (int d = 0; d < 4; ++d)
#pragma unroll
                    for (int r = 0; r < 16; ++r) { const float v = o[d][r] * inv - lam * exch[(d * 16 + r) * 64 + lane]; o[d][r] = v; ss += v * v; }
                ss += __shfl_xor(ss, 32);
                const float rn = rsqrtf(ss * (1.f / 128.f) + EPS) * (1.f - lambda_init);
                f32x4 w4s[4][4];
#pragma unroll
                for (int d = 0; d < 4; ++d)
#pragma unroll
                    for (int g4 = 0; g4 < 4; ++g4) w4s[d][g4] = *(const f32x4*)(sublnw + 32 * d + 8 * g4 + 4 * hi);
                if (!metaq || l31 < 16) {
                    bf16_t* orow = O + (size_t)qrow * 1024 + h * 128;
#pragma unroll
                    for (int d = 0; d < 4; ++d)
#pragma unroll
                        for (int g4 = 0; g4 < 4; ++g4) {
                            const int dd = 32 * d + 8 * g4 + 4 * hi;
                            const f32x4 w4 = w4s[d][g4];
                            u32x2 w; w.x = pk_bf16(o[d][4 * g4] * rn * w4.x, o[d][4 * g4 + 1] * rn * w4.y); w.y = pk_bf16(o[d][4 * g4 + 2] * rn * w4.z, o[d][4 * g4 + 3] * rn * w4.w);
                            *(u32x2*)(orow + dd) = w;
                        }
                }
            }
            __syncthreads();
#undef ATT_DMA_K
#undef ATT_DMA_V
#undef ATT_QK
#undef ATT_PV
        }
    }
}

constexpr int GP_PITCH = 520;
__device__ __forceinline__ void gla_prep(LAS unsigned char* lds, const bf16_t* QK, const float* gz, const float* Wg, const float* bias,
                                         bf16_t* QPimg, bf16_t* KTimg, bf16_t* Aimg, float* dec, int G) {
    const int tid = opaque_tid(), lane = tid & 63, wid = __builtin_amdgcn_readfirstlane(tid >> 6), l31 = lane & 31, hi = lane >> 5;
    LAS float* gzs = (LAS float*)lds;
    LAS bf16_t* Qs = (LAS bf16_t*)(lds + 4096);
    LAS bf16_t* Ks = (LAS bf16_t*)(lds + 4096 + 64 * GP_PITCH * 2);
    const int hh = tid >> 7, dk = tid & 127;
    float wg[16];
#pragma unroll
    for (int r = 0; r < 16; ++r) wg[r] = Wg[r * 512 + tid];
    const float bi = bias[tid];
    for (int u = blockIdx.x; u < 513; u += G) {
        const int m0 = (u < 512) ? (u >> 6) * SEQ + (u & 63) * 64 : MR; const int ntok = (u < 512) ? 64 : 16;
        u32x4 raw[16];
#pragma unroll
        for (int i = 0; i < 16; ++i) { const int row = 4 * i + (tid >> 7); raw[i] = (u32x4){0u, 0u, 0u, 0u}; if (row < ntok) raw[i] = *(const u32x4*)(QK + (size_t)(m0 + row) * 1024 + (tid & 127) * 8); }
        if (tid < 256) { const int t = tid >> 2, q4 = tid & 3; f32x4 v = {0.f, 0.f, 0.f, 0.f}; if (t < ntok) v = *(const f32x4*)(gz + (size_t)(m0 + t) * 16 + q4 * 4); *(LAS f32x4*)(gzs + t * 16 + q4 * 4) = v; }
        { LAS bf16_t* dstb = (tid & 64) ? Ks : Qs; const int colb = ((tid & 127) * 8) & 511;
#pragma unroll
          for (int i = 0; i < 16; ++i) *(LAS u32x4*)(dstb + (4 * i + (tid >> 7)) * GP_PITCH + colb) = raw[i]; }
        __syncthreads();
        float bb[64]; float bs = 0.f;
#pragma unroll
        for (int t = 0; t < 64; ++t) {
            if (t < ntok) {
                float x = bi;
#pragma unroll
                for (int q4 = 0; q4 < 4; ++q4) { const f32x4 g4 = *(const LAS f32x4*)(gzs + t * 16 + q4 * 4); x += g4.x * wg[4 * q4] + g4.y * wg[4 * q4 + 1] + g4.z * wg[4 * q4 + 2] + g4.w * wg[4 * q4 + 3]; }
                const float ls = fminf(x, 0.f) - __logf(1.f + __expf(-fabsf(x)));
                bs += ls * (1.f / 16.f);
            }
            bb[t] = bs;
        }
        const float blast = bs;
#pragma unroll
        for (int t8 = 0; t8 < 8; ++t8) {
            float kh[8];
#pragma unroll
            for (int tt = 0; tt < 8; ++tt) { const int t = t8 * 8 + tt;
                const float qv = bf2f(Qs[t * GP_PITCH + tid]), kv = bf2f(Ks[t * GP_PITCH + tid]);
                Qs[t * GP_PITCH + tid] = f2bf(qv * __expf(bb[t]) * 0.08838834764831845f);
                Ks[t * GP_PITCH + tid] = f2bf(kv * __expf(-bb[t]));
                kh[tt] = kv * __expf(blast - bb[t]); }
            u32x4 w; w.x = pk_bf16(kh[0], kh[1]); w.y = pk_bf16(kh[2], kh[3]); w.z = pk_bf16(kh[4], kh[5]); w.w = pk_bf16(kh[6], kh[7]);
            *(u32x4*)(KTimg + ((((size_t)u * 4 + hh) * 8 + t8) * 128 + dk) * 8) = w;
        }
        dec[((size_t)u * 4 + hh) * 256 + dk] = __expf(blast);
        __syncthreads();
#pragma unroll
        for (int i = 0; i < 8; ++i) { const int it = tid + 512 * i, t = it & 63, ch = (it >> 6) & 15, h2 = it >> 10; const int dkb = 32 * (ch >> 2) + 16 * ((ch >> 1) & 1) + 4 * (ch & 1);
            const u32x2 a = *(const LAS u32x2*)(Qs + t * GP_PITCH + h2 * 128 + dkb), b2 = *(const LAS u32x2*)(Qs + t * GP_PITCH + h2 * 128 + dkb + 8);
            *(u32x4*)(QPimg + ((((size_t)u * 4 + h2) * 16 + ch) * 64 + t) * 8) = (u32x4){a.x, a.y, b2.x, b2.y}; }
        { const int h2 = wid >> 1, tt = wid & 1; const int t = 32 * tt + l31;
#pragma unroll
          for (int jt = 0; jt < 2; ++jt) {
            f32x16 acc;
#pragma unroll
            for (int r = 0; r < 16; ++r) acc[r] = 0.f;
#pragma unroll
            for (int ks = 0; ks < 8; ++ks) {
                const bf16x8 af = *(const LAS bf16x8*)(Ks + (32 * jt + l31) * GP_PITCH + h2 * 128 + 16 * ks + 8 * hi);
                const bf16x8 bf = *(const LAS bf16x8*)(Qs + t * GP_PITCH + h2 * 128 + 16 * ks + 8 * hi);
                acc = __builtin_amdgcn_mfma_f32_32x32x16_bf16(af, bf, acc, 0, 0, 0);
            }
#pragma unroll
            for (int g4 = 0; g4 < 4; ++g4) { float v[4];
#pragma unroll
                for (int e = 0; e < 4; ++e) { const int jj = 32 * jt + 8 * g4 + 4 * hi + e; v[e] = (jj <= t) ? acc[4 * g4 + e] : 0.f; }
                u32x2 w; w.x = pk_bf16(v[0], v[1]); w.y = pk_bf16(v[2], v[3]);
                *(u32x2*)(Aimg + ((((size_t)u * 4 + h2) * 8 + (4 * jt + g4)) * 64 + t) * 8 + 4 * hi) = w; }
          } }
        __syncthreads();
    }
}

constexpr int GS_QP = 0, GS_KT = 16384, GS_A = 32768, GS_VT = 40960, GS_DEC = 49152, GS_STAGE = 50176, GS_NPIECE = 49;
static_assert(3 * GS_STAGE <= 153600, "scan ring fits below the barrier words");
__device__ __forceinline__ void gla_scan(LAS unsigned char* lds, const bf16_t* QPimg, const bf16_t* KTimg, const bf16_t* Aimg, const bf16_t* VTimg, const bf16_t* VTmeta,
                                         const float* dec, bf16_t* Oraw) {
    if (blockIdx.x >= 128) return;
    const int tid = opaque_tid(), lane = tid & 63, wid = __builtin_amdgcn_readfirstlane(tid >> 6), l31 = lane & 31, hi = lane >> 5;
    const int bh = blockIdx.x & 31, quarter = blockIdx.x >> 5, b = bh >> 2, h = bh & 3;
    const bool worker = wid < 2;
    const int w8 = quarter * 2 + wid;
    const unsigned ldsb = (unsigned)(uintptr_t)lds;
#define GS_ISSUE(cc, slot) do { const size_t iu_ = ((cc) == 0) ? 512 : (size_t)b * 64 + (cc) - 1; const size_t ih_ = iu_ * 4 + h; \
        const char* vsrc_ = (const char*)(((cc) == 0) ? VTmeta + (size_t)h * 16384 : VTimg + ((size_t)(b * 4 + h) * 64 + (cc) - 1) * 16384); \
        for (int p_ = wid - 2; p_ < GS_NPIECE; p_ += 6) { const char* src_; \
            if (p_ < 16) src_ = (const char*)(QPimg + ih_ * 8192) + p_ * 1024; \
            else if (p_ < 32) src_ = (const char*)(KTimg + ih_ * 8192) + (p_ - 16) * 1024; \
            else if (p_ < 40) src_ = (const char*)(Aimg + ih_ * 4096) + (p_ - 32) * 1024; \
            else if (p_ < 48) src_ = vsrc_ + ((p_ - 40) * 256 + quarter * 64) * 16; \
            else src_ = (const char*)(dec + ih_ * 256); \
            glds16(src_ + lane * 16, (unsigned)__builtin_amdgcn_readfirstlane(ldsb + (slot) * GS_STAGE + p_ * 1024)); } } while (0)
    f32x16 S[4];
#pragma unroll
    for (int T = 0; T < 4; ++T)
#pragma unroll
        for (int r = 0; r < 16; ++r) S[T][r] = 0.f;
    if (!worker) { GS_ISSUE(0, 0); GS_ISSUE(1, 1); }
    WAITV_BAR(0);
    int slot = 0;
    for (int cc = 0; cc <= 64; ++cc) {
        if (!worker) {
            if (cc + 2 <= 64) { const int s2 = slot == 0 ? 2 : slot - 1; GS_ISSUE(cc + 2, s2); }
        } else {
            const LAS unsigned char* st = lds + slot * GS_STAGE;
#define GA(tt, s4) (*(const LAS bf16x8*)(st + GS_A + ((2 * (s4) + hi) * 64 + 32 * (tt) + l31) * 16))
#define GQ(tt, p) (*(const LAS bf16x8*)(st + GS_QP + ((((p) >> 1) * 4 + ((p) & 1) * 2 + hi) * 64 + 32 * (tt) + l31) * 16))
#define GK(s4, T) (*(const LAS bf16x8*)(st + GS_KT + ((2 * (s4) + hi) * 128 + 32 * (T) + l31) * 16))
#define RD_A(F, k) do { F[0] = GA(0, 2 * (k)); F[1] = GA(1, 2 * (k)); F[2] = GA(0, 2 * (k) + 1); F[3] = GA(1, 2 * (k) + 1); } while (0)
#define MM_A(F, k) do { acc0 = __builtin_amdgcn_mfma_f32_32x32x16_bf16(vf[2 * (k)], F[0], acc0, 0, 0, 0); acc1 = __builtin_amdgcn_mfma_f32_32x32x16_bf16(vf[2 * (k)], F[1], acc1, 0, 0, 0); \
                        acc0 = __builtin_amdgcn_mfma_f32_32x32x16_bf16(vf[2 * (k) + 1], F[2], acc0, 0, 0, 0); acc1 = __builtin_amdgcn_mfma_f32_32x32x16_bf16(vf[2 * (k) + 1], F[3], acc1, 0, 0, 0); } while (0)
#define RD_Q(F, k) do { F[0] = GQ(0, 2 * (k)); F[1] = GQ(1, 2 * (k)); F[2] = GQ(0, 2 * (k) + 1); F[3] = GQ(1, 2 * (k) + 1); } while (0)
#define MM_Q(F, k) do { acc0 = __builtin_amdgcn_mfma_f32_32x32x16_bf16(sb[k][0], F[0], acc0, 0, 0, 0); acc1 = __builtin_amdgcn_mfma_f32_32x32x16_bf16(sb[k][0], F[1], acc1, 0, 0, 0); \
                        acc0 = __builtin_amdgcn_mfma_f32_32x32x16_bf16(sb[k][1], F[2], acc0, 0, 0, 0); acc1 = __builtin_amdgcn_mfma_f32_32x32x16_bf16(sb[k][1], F[3], acc1, 0, 0, 0); } while (0)
#define RD_K(F, s4) do { F[0] = GK(s4, 0); F[1] = GK(s4, 1); F[2] = GK(s4, 2); F[3] = GK(s4, 3); } while (0)
#define MM_K(F, s4) do { _Pragma("unroll") for (int T = 0; T < 4; ++T) S[T] = __builtin_amdgcn_mfma_f32_32x32x16_bf16(F[T], vf[s4], S[T], 0, 0, 0); } while (0)
#define SBAR __builtin_amdgcn_sched_barrier(0)
            bf16x8 vf[4], fa[4], fb[4];
#pragma unroll
            for (int s4 = 0; s4 < 4; ++s4) vf[s4] = *(const LAS bf16x8*)(st + GS_VT + ((2 * s4 + hi) * 64 + 32 * wid + l31) * 16);
            RD_A(fa, 0); SBAR; RD_A(fb, 1);
            bf16x8 sb[4][2];
#pragma unroll
            for (int T = 0; T < 4; ++T)
#pragma unroll
                for (int s2 = 0; s2 < 2; ++s2) { u32x4 w;
#pragma unroll
                    for (int q4 = 0; q4 < 4; ++q4) w[q4] = pk_bf16(S[T][8 * s2 + 2 * q4], S[T][8 * s2 + 2 * q4 + 1]);
                    sb[T][s2] = __builtin_bit_cast(bf16x8, w); }
            f32x16 acc0, acc1;
#pragma unroll
            for (int r = 0; r < 16; ++r) { acc0[r] = 0.f; acc1[r] = 0.f; }
            SBAR; MM_A(fa, 0); SBAR; RD_Q(fa, 0); SBAR; MM_A(fb, 1); SBAR; RD_Q(fb, 1); SBAR; MM_Q(fa, 0); SBAR; RD_Q(fa, 2); SBAR; MM_Q(fb, 1); SBAR; RD_Q(fb, 3); SBAR; MM_Q(fa, 2); SBAR; RD_K(fa, 0); SBAR; MM_Q(fb, 3);
            if (cc > 0 || b == 0) {
                bf16_t* ob = Oraw + (((cc == 0) ? (size_t)512 : (size_t)b * 64 + cc - 1) * 4 + h) * 16384 + (size_t)(w8 * 8) * 256 + lane * 4;
#pragma unroll
                for (int g4 = 0; g4 < 4; ++g4) { u32x2 w; w.x = pk_bf16(acc0[4 * g4], acc0[4 * g4 + 1]); w.y = pk_bf16(acc0[4 * g4 + 2], acc0[4 * g4 + 3]); *(u32x2*)(ob + g4 * 256) = w; }
#pragma unroll
                for (int g4 = 0; g4 < 4; ++g4) { u32x2 w; w.x = pk_bf16(acc1[4 * g4], acc1[4 * g4 + 1]); w.y = pk_bf16(acc1[4 * g4 + 2], acc1[4 * g4 + 3]); *(u32x2*)(ob + (4 + g4) * 256) = w; }
            }
#pragma unroll
            for (int T = 0; T < 4; ++T)
#pragma unroll
                for (int g4 = 0; g4 < 4; ++g4) { const f32x4 d4 = *(const LAS f32x4*)(st + GS_DEC + (32 * T + 8 * g4 + 4 * hi) * 4);
                    S[T][4 * g4] *= d4.x; S[T][4 * g4 + 1] *= d4.y; S[T][4 * g4 + 2] *= d4.z; S[T][4 * g4 + 3] *= d4.w; }
            SBAR; RD_K(fb, 1); SBAR; MM_K(fa, 0); SBAR; RD_K(fa, 2); SBAR; MM_K(fb, 1); SBAR; RD_K(fb, 3); SBAR; MM_K(fa, 2); SBAR; MM_K(fb, 3);
#undef GA
#undef GQ
#undef GK
#undef RD_A
#undef MM_A
#undef RD_Q
#undef MM_Q
#undef RD_K
#undef MM_K
#undef SBAR
        }
        if (worker) { asm volatile("s_waitcnt lgkmcnt(0)\n\ts_barrier" ::: "memory"); }
        else if (cc + 2 > 64) { WAITV_BAR(0); }
        else if (wid == 2) { WAITV_BAR(9); }
        else { WAITV_BAR(8); }
        slot = slot == 2 ? 0 : slot + 1;
    }
#undef GS_ISSUE
}

__device__ __forceinline__ void gla_finalize(LAS unsigned char* lds, const bf16_t* Oraw, const bf16_t* Gb, const float* normw, bf16_t* Oout, int G) {
    const int tid = opaque_tid(), lane = tid & 63, wid = __builtin_amdgcn_readfirstlane(tid >> 6);
    constexpr int FP = 264;
    LAS bf16_t* tile = (LAS bf16_t*)lds;
    const f32x4 nw = *(const f32x4*)(normw + 4 * lane);
    for (int u = blockIdx.x; u < 513 * 4; u += G) {
        const int iu = u >> 2, h = u & 3;
        const bf16_t* img = Oraw + (size_t)u * 16384;
        const int ntok = iu < 512 ? 64 : 16; const int m0 = iu < 512 ? (iu >> 6) * SEQ + (iu & 63) * 64 : MR;
        u32x2 iv[8], gg[8];
#pragma unroll
        for (int i = 0; i < 8; ++i) iv[i] = *(const u32x2*)(img + ((size_t)(wid + 8 * i) * 64 + lane) * 4);
#pragma unroll
        for (int i = 0; i < 8; ++i) { const int t = wid * 8 + i; gg[i] = *(const u32x2*)(Gb + (size_t)(m0 + (t < ntok ? t : 0)) * 1024 + h * 256 + 4 * lane); }
#pragma unroll
        for (int i = 0; i < 8; ++i) { const int combo = wid + 8 * i, g4 = combo & 3, tt = (combo >> 2) & 1, w = combo >> 3;
            const int t = 32 * tt + (lane & 31), dv = 32 * w + 8 * g4 + 4 * (lane >> 5);
            *(LAS u32x2*)(tile + t * FP + dv) = iv[i]; }
        __syncthreads();
        float o[8][4], sq[8];
#pragma unroll
        for (int i = 0; i < 8; ++i) { const u32x2 v = *(const LAS u32x2*)(tile + (wid * 8 + i) * FP + 4 * lane);
            o[i][0] = __uint_as_float(v.x << 16); o[i][1] = __uint_as_float(v.x & 0xffff0000u); o[i][2] = __uint_as_float(v.y << 16); o[i][3] = __uint_as_float(v.y & 0xffff0000u);
            sq[i] = (o[i][0] * o[i][0] + o[i][1] * o[i][1]) + (o[i][2] * o[i][2] + o[i][3] * o[i][3]); }
#pragma unroll
        for (int st = 1; st < 64; st <<= 1)
#pragma unroll
            for (int i = 0; i < 8; ++i) sq[i] += __shfl_xor(sq[i], st);
#pragma unroll
        for (int i = 0; i < 8; ++i) { const int t = wid * 8 + i;
            const float rinv = rsqrtf(sq[i] * (1.f / 256.f) + EPS);
            const float g0 = __uint_as_float(gg[i].x << 16), g1 = __uint_as_float(gg[i].x & 0xffff0000u), g2 = __uint_as_float(gg[i].y << 16), g3 = __uint_as_float(gg[i].y & 0xffff0000u);
            u32x2 w; w.x = pk_bf16(o[i][0] * rinv * nw.x * (g0 / (1.f + __expf(-g0))), o[i][1] * rinv * nw.y * (g1 / (1.f + __expf(-g1))));
            w.y = pk_bf16(o[i][2] * rinv * nw.z * (g2 / (1.f + __expf(-g2))), o[i][3] * rinv * nw.w * (g3 / (1.f + __expf(-g3))));
            if (t < ntok) *(u32x2*)(Oout + (size_t)(m0 + t) * 1024 + h * 256 + 4 * lane) = w; }
        __syncthreads();
    }
}

struct Args { Ptrs p; };


#define XB_TMO      128
#define XB_XCNT(j)  (256  + 64 * (j))
#define XB_XSUB(j)  (1280 + 64 * (j))
#define XB_XGEN(j)  (2304 + 64 * (j))
#define XB_TOP      3328
#define XB_TOPGEN   3392
#define XCD_BAR_WORDS 3456
#define XB_SPIN_CAP (1u << 18)

__device__ __forceinline__ unsigned xb_ld(unsigned* p)              { return __hip_atomic_load(p, __ATOMIC_RELAXED, __HIP_MEMORY_SCOPE_AGENT); }
__device__ __forceinline__ unsigned xb_add(unsigned* p, unsigned v) { return __hip_atomic_fetch_add(p, v, __ATOMIC_RELAXED, __HIP_MEMORY_SCOPE_AGENT); }
__device__ __forceinline__ unsigned xb_xcc_id() { return (unsigned)__builtin_amdgcn_s_getreg((3 << 11) | 20) & 0xFu; }
#define XB_SPIN(cond, bar) do { unsigned _sp = 0; while (cond) { __builtin_amdgcn_s_sleep(1); \
    if ((++_sp & 255u) == 0u) { if (xb_ld(&(bar)[XB_TMO])) break; if (_sp > XB_SPIN_CAP) { atomicAdd(&(bar)[XB_TMO], 1u); break; } } } } while (0)

struct XcdBarrier {
    unsigned* bar; unsigned x;
    volatile LAS unsigned* st;
};

__device__ __forceinline__ XcdBarrier xcd_barrier_post(unsigned* bar, volatile LAS unsigned* st) {
    XcdBarrier b; b.bar = bar; b.x = xb_xcc_id(); b.st = st;
    if (threadIdx.x == 0) (void)xb_add(&bar[XB_XCNT(b.x)], 1u);
    return b;
}
__device__ __forceinline__ void xcd_barrier_complete(unsigned* bar, unsigned x, unsigned& nloc, unsigned& nx) {
    const unsigned G = gridDim.x * gridDim.y * gridDim.z;
    unsigned sum, cnt, mine, sp = 0u;
    for (;;) {
        sum = 0u; cnt = 0u; mine = 0u;
#pragma unroll
        for (unsigned j = 0; j < 16; ++j) { const unsigned c = xb_ld(&bar[XB_XCNT(j)]); sum += c; cnt += (c > 0u) ? 1u : 0u; mine = (j == x) ? c : mine; }
        if (sum == G) break;
        __builtin_amdgcn_s_sleep(1);
        if ((++sp & 255u) == 0u) { if (xb_ld(&bar[XB_TMO])) break; if (sp > XB_SPIN_CAP) { atomicAdd(&bar[XB_TMO], 1u); break; } }
    }
    nloc = mine > 0u ? mine : 1u; nx = cnt > 0u ? cnt : 1u;
}

__device__ __forceinline__ void xcd_barrier(const XcdBarrier& b) {
    asm volatile("s_waitcnt vmcnt(0)" ::: "memory");
    __syncthreads();
    if (threadIdx.x == 0) {
        unsigned* bar = b.bar;
        __builtin_amdgcn_s_waitcnt(0);
        unsigned nloc = b.st[0], nx = b.st[1];
        if (nloc == 0u) { xcd_barrier_complete(bar, b.x, nloc, nx); b.st[0] = nloc; b.st[1] = nx; }
        const unsigned old = xb_add(&bar[XB_XSUB(b.x)], 1u);
        const unsigned gen = old / nloc;
        if (old + 1u == (gen + 1u) * nloc) {
            __builtin_amdgcn_fence(__ATOMIC_RELEASE, "agent");
            asm volatile("s_waitcnt vmcnt(0)" ::: "memory");
            const unsigned og = xb_add(&bar[XB_TOP], 1u);
            const unsigned tg = og / nx;
            if (og + 1u == (tg + 1u) * nx) xb_add(&bar[XB_TOPGEN], 1u);
            else XB_SPIN(xb_ld(&bar[XB_TOPGEN]) == tg, bar);
            __builtin_amdgcn_fence(__ATOMIC_ACQUIRE, "agent");
            xb_add(&bar[XB_XGEN(b.x)], 1u);
            asm volatile("s_waitcnt vmcnt(0)" ::: "memory");
        } else {
            XB_SPIN(xb_ld(&bar[XB_XGEN(b.x)]) == gen, bar);
            __builtin_amdgcn_fence(__ATOMIC_ACQUIRE, "agent");
            asm volatile("s_waitcnt vmcnt(0)" ::: "memory");
        }
    }
    __syncthreads();
}

#define KARGS() ({ KP k_ = (KP)__builtin_amdgcn_kernarg_segment_ptr(); asm volatile("" : "+s"(k_)); k_; })
#define PHASE_BEGIN KP P = KARGS(); unsigned char* const ws = P->ws; const int G = gridDim.x; float* const hreal = P->out; float* const hmeta = (float*)(ws + WS_HMETA); bf16_t* const HN = (bf16_t*)(ws + WS_HN); (void)hreal; (void)hmeta; (void)HN; (void)G;

__global__ void __launch_bounds__(NTHR, 2) hybrid_fwd(Args args) {
    extern __shared__ __attribute__((aligned(16))) unsigned char lds_raw[];
    LAS unsigned char* lds = (LAS unsigned char*)lds_raw;
    cg::grid_group grid = cg::this_grid();
    if (threadIdx.x < 64) ((LAS unsigned*)(lds + LDS_BAR_OFF))[threadIdx.x] = 0u;
    __syncthreads();
    { KP Pb = KARGS(); (void)xcd_barrier_post((unsigned*)(Pb->ws + WS_CTL), (volatile LAS unsigned*)(lds + LDS_BAR_OFF)); }
#define GSYNC() do { KP Pb_ = KARGS(); XcdBarrier b_; b_.bar = (unsigned*)(Pb_->ws + WS_CTL); b_.x = xb_xcc_id(); b_.st = (volatile LAS unsigned*)(lds + LDS_BAR_OFF); xcd_barrier(b_); } while (0)

    { KP P0 = KARGS(); p0_prologue(P0, lds, gridDim.x); }

    for (int layer = 0; layer < 4; ++layer) {
        asm volatile("" : "+s"(layer));
        const int j = layer >> 1;
        {   PHASE_BEGIN
            const int gt = blockIdx.x * NTHR + opaque_tid(), NGT = G * NTHR;
            u32x4* z = (u32x4*)(ws + ((layer & 1) ? GB_VTMETA : AB_KMETA)); const int nz = ((layer & 1) ? 131072 : 262144) / 16;
            for (int e = gt; e < nz; e += NGT) z[e] = (u32x4){0u, 0u, 0u, 0u};
            norm_phase(layer == 0 ? P->x : hreal, layer == 0 ? P->meta : hmeta, P->mix_w + layer * DM, HN, G);
        }
        if (layer == 0) grid.sync(); else GSYNC();
        if ((layer & 1) == 0) {
            {   PHASE_BEGIN
                const bf16_t* Wqkv = (const bf16_t*)(ws + WS_WQKV + j * WS_WQKV_STRIDE);
                bf16_t* Qb = (bf16_t*)(ws + AB_Q); bf16_t* Kimg = (bf16_t*)(ws + AB_KIMG);
                pg8::Gemm g{HN, Wqkv, MR, 2048, DM}; pg8::StaticOrder S; S.init(MR, 2048, G, (int)blockIdx.x);
                pg8::EpiB E{pg8::EM_ATT_QK, Qb, Kimg, QSCALE};
                pg8::gemm_phase<pg8::EpiB, pg8::StaticOrder, true, true>(lds, g, S, E); }
            {   PHASE_BEGIN
                const bf16_t* Wqkv = (const bf16_t*)(ws + WS_WQKV + j * WS_WQKV_STRIDE); bf16_t* Vimg = (bf16_t*)(ws + AB_VIMG);
                pg8::Gemm g{Wqkv + (size_t)2048 * DM, HN, 1024, MR, DM}; pg8::StaticOrder S; S.init(1024, MR, G, (int)blockIdx.x);
                pg8::EpiB E{pg8::EM_ATT_VT, Vimg, nullptr, 1.f};
                pg8::gemm_phase<pg8::EpiB, pg8::StaticOrder, true, true>(lds, g, S, E); }
            {   PHASE_BEGIN
                const bf16_t* Wqkv = (const bf16_t*)(ws + WS_WQKV + j * WS_WQKV_STRIDE);
                MiniEpi ME{MM_ATT, ws + AB_Q, ws + AB_KMETA, ws + AB_VMETA, nullptr}; mini_gemm(lds, HN + (size_t)MR * DM, Wqkv, 3072, DM, ME, G); }
            GSYNC();
#ifndef SKIP_ATT
            {   PHASE_BEGIN
                attn_phase(lds, (const bf16_t*)(ws + AB_Q), (const bf16_t*)(ws + AB_KIMG), (const bf16_t*)(ws + AB_VIMG), (const bf16_t*)(ws + AB_KMETA), (const bf16_t*)(ws + AB_VMETA),
                           HN, P->attn_lam + j * 256, P->attn_subln + j * 128, layer == 0 ? 0.2f : 0.47071301834303590f, G); }
#endif
            GSYNC();
            {   PHASE_BEGIN
                const bf16_t* Wo = (const bf16_t*)(ws + WS_WAO + j * WS_WAO_STRIDE);
                pg8::Gemm g{HN, Wo, MR, DM, DM}; pg8::StaticOrder S; S.init(MR, DM, G, (int)blockIdx.x);
                pg8::EpiRes E{layer == 0 ? P->x : hreal, hreal};
                pg8::gemm_phase<pg8::EpiRes, pg8::StaticOrder, true, true>(lds, g, S, E); }
            {   PHASE_BEGIN
                const bf16_t* Wo = (const bf16_t*)(ws + WS_WAO + j * WS_WAO_STRIDE);
                MiniEpi ME{MM_RES, hmeta, nullptr, nullptr, layer == 0 ? P->meta : hmeta}; mini_gemm(lds, HN + (size_t)MR * DM, Wo, DM, DM, ME, G); }
            GSYNC();
        } else {
            {   PHASE_BEGIN
                const bf16_t* Wg = (const bf16_t*)(ws + WS_WGLA + j * WS_WGLA_STRIDE);
                pg8::Gemm g{HN, Wg, MR, 2048, DM}; pg8::StaticOrder S; S.init(MR, 2048, G, (int)blockIdx.x);
                pg8::EpiB E{pg8::EM_GLA_QKG, (bf16_t*)(ws + GB_QK), (bf16_t*)(ws + GB_G), 1.f};
                pg8::gemm_phase<pg8::EpiB, pg8::StaticOrder, true, true>(lds, g, S, E); }
            {   PHASE_BEGIN
                const bf16_t* Wg = (const bf16_t*)(ws + WS_WGLA + j * WS_WGLA_STRIDE);
                pg8::Gemm g{Wg + (size_t)2048 * DM, HN, 1024, MR, DM}; pg8::StaticOrder S; S.init(1024, MR, G, (int)blockIdx.x);
                pg8::EpiB E{pg8::EM_GLA_VT, (bf16_t*)(ws + GB_VT), nullptr, 1.f};
                pg8::gemm_phase<pg8::EpiB, pg8::StaticOrder, true, true>(lds, g, S, E); }
            {   PHASE_BEGIN
                const bf16_t* Wg = (const bf16_t*)(ws + WS_WGLA + j * WS_WGLA_STRIDE);
                MiniEpi ME{MM_GLA, ws + GB_QK, ws + GB_G, ws + GB_VTMETA, nullptr}; mini_gemm(lds, HN + (size_t)MR * DM, Wg, 3072, DM, ME, G); }
            {   PHASE_BEGIN
                const bf16_t* Wg = (const bf16_t*)(ws + WS_WGLA + j * WS_WGLA_STRIDE);
                gz_gemm(Wg + (size_t)3072 * DM, HN, (float*)(ws + GB_GZ), G); }
            GSYNC();
#ifndef SKIP_PREP
            {   PHASE_BEGIN
                gla_prep(lds, (const bf16_t*)(ws + GB_QK), (const float*)(ws + GB_GZ), P->gla_w_gate + j * 16 * 512, P->gla_bias + j * 512,
                         (bf16_t*)(ws + GB_QP), (bf16_t*)(ws + GB_KT), (bf16_t*)(ws + GB_A), (float*)(ws + GB_DEC), G); }
#endif
            GSYNC();
#ifndef SKIP_SCAN
            {   PHASE_BEGIN
                gla_scan(lds, (const bf16_t*)(ws + GB_QP), (const bf16_t*)(ws + GB_KT), (const bf16_t*)(ws + GB_A), (const bf16_t*)(ws + GB_VT), (const bf16_t*)(ws + GB_VTMETA),
                         (const float*)(ws + GB_DEC), (bf16_t*)(ws + GB_ORAW)); }
#endif
            GSYNC();
            {   PHASE_BEGIN
                gla_finalize(lds, (const bf16_t*)(ws + GB_ORAW), (const bf16_t*)(ws + GB_G), P->gla_norm + j * 256, HN, G); }
            GSYNC();
            {   PHASE_BEGIN
                const bf16_t* Wo = (const bf16_t*)(ws + WS_WGO + j * WS_WGO_STRIDE);
                pg8::Gemm g{HN, Wo, MR, DM, DM}; pg8::StaticOrder S; S.init(MR, DM, G, (int)blockIdx.x);
                pg8::EpiRes E{hreal, hreal};
                pg8::gemm_phase<pg8::EpiRes, pg8::StaticOrder, true, true>(lds, g, S, E); }
            {   PHASE_BEGIN
                const bf16_t* Wo = (const bf16_t*)(ws + WS_WGO + j * WS_WGO_STRIDE);
                MiniEpi ME{MM_RES, hmeta, nullptr, nullptr, hmeta}; mini_gemm(lds, HN + (size_t)MR * DM, Wo, DM, DM, ME, G); }
            GSYNC();
        }
        {   PHASE_BEGIN
            norm_phase(hreal, hmeta, P->mlp_norm + layer * DM, HN, G); }
        GSYNC();
        {   PHASE_BEGIN
            const bf16_t* Wu = (const bf16_t*)(ws + WS_WUP + layer * WS_WUP_STRIDE); bf16_t* U = (bf16_t*)(ws + MB_U);
            pg8::Gemm g{HN, Wu, MR, FF, DM}; pg8::StaticOrder S; S.init(MR, FF, G, (int)blockIdx.x);
            pg8::EpiB E{pg8::EM_RELU2, U, nullptr, 1.f};
            pg8::gemm_phase<pg8::EpiB, pg8::StaticOrder, true, true>(lds, g, S, E); }
        {   PHASE_BEGIN
            const bf16_t* Wu = (const bf16_t*)(ws + WS_WUP + layer * WS_WUP_STRIDE);
            MiniEpi ME{MM_RELU2, ws + MB_U, nullptr, nullptr, nullptr}; mini_gemm(lds, HN + (size_t)MR * DM, Wu, FF, DM, ME, G); }
        GSYNC();
        {   PHASE_BEGIN
            const bf16_t* Wd = (const bf16_t*)(ws + WS_WDN + layer * WS_WDN_STRIDE); const bf16_t* U = (const bf16_t*)(ws + MB_U);
            pg8::Gemm g{U, Wd, MR, DM, FF}; pg8::StaticOrder S; S.init(MR, DM, G, (int)blockIdx.x);
            pg8::EpiRes E{hreal, hreal};
            pg8::gemm_phase<pg8::EpiRes, pg8::StaticOrder, true, true>(lds, g, S, E); }
        {   PHASE_BEGIN
            const bf16_t* Wd = (const bf16_t*)(ws + WS_WDN + layer * WS_WDN_STRIDE); const bf16_t* U = (const bf16_t*)(ws + MB_U);
            MiniEpi ME{MM_RES, hmeta, nullptr, nullptr, hmeta}; mini_gemm(lds, U + (size_t)MR * FF, Wd, DM, FF, ME, G); }
        GSYNC();
    }
    {   PHASE_BEGIN
        final_norm_phase(hreal, P->final_w, G); }
}

extern "C" void kernel_launch(void* const* d_in, const int* in_sizes, int n_in, void* d_out, int out_size, void* d_ws, size_t ws_size, hipStream_t stream) {
    static int grid = 0;
    if (grid == 0) {
        if (n_in != 16 || out_size != MR * DM || ws_size < WS_END) { fprintf(stderr, "kernel_launch: unexpected shapes (n_in %d out %d ws %zu need %zu)\n", n_in, out_size, ws_size, (size_t)WS_END); grid = -1; return; }
        int dev = 0, cus = 0, per_cu = 0;
        hipGetDevice(&dev);
        hipDeviceGetAttribute(&cus, hipDeviceAttributeMultiprocessorCount, dev);
        hipFuncSetAttribute((const void*)hybrid_fwd, hipFuncAttributeMaxDynamicSharedMemorySize, LDS_BYTES);
        hipOccupancyMaxActiveBlocksPerMultiprocessor(&per_cu, (const void*)hybrid_fwd, NTHR, LDS_BYTES);
        if (per_cu < 1) { fprintf(stderr, "kernel_launch: occupancy query says %d blocks per CU\n", per_cu); per_cu = 1; }
        grid = cus;
        (void)hipGetLastError();
    }
    if (grid < 0) return;
    if (hipMemsetAsync((char*)d_ws + WS_CTL, 0, 16384, stream) != hipSuccess) { fprintf(stderr, "kernel_launch: memset of the barrier words failed\n"); return; }
    Args a{};
    const float** pp = (const float**)&a.p;
    for (int i = 0; i < 16; ++i) pp[i] = (const float*)d_in[i];
    a.p.out = (float*)d_out; a.p.ws = (unsigned char*)d_ws;
    void* kargs[] = {&a};
    hipError_t e = hipLaunchCooperativeKernel((const void*)hybrid_fwd, dim3(grid), dim3(NTHR), kargs, LDS_BYTES, stream);
    if (e != hipSuccess) fprintf(stderr, "cooperative launch failed: %s (grid %d)\n", hipGetErrorString(e), grid);
}
```

```cpp
#include <hip/hip_runtime.h>
#include <hip/hip_cooperative_groups.h>
#include <cstdio>
#include <cstdint>
#include <cmath>
namespace cg = cooperative_groups;
__device__ __forceinline__ int opaque_tid() { int t = threadIdx.x; asm volatile("" : "+v"(t)); return t; }
namespace pg8 {
#define PG8_LAS __attribute__((address_space(3)))
typedef unsigned short bf16_t;
typedef short bf16x8 __attribute__((ext_vector_type(8)));
typedef float f32x4 __attribute__((ext_vector_type(4)));
typedef unsigned u32x4 __attribute__((ext_vector_type(4)));
constexpr int BM = 256, BK = 64, HALF = 128, HTB = HALF * BK * 2  , STAGE_BYTES = 8 * HTB, NXCD = 8, WGM = 8;

__host__ __device__ __forceinline__ int lds_byte(int r, int c) { const int st = (r >> 4) * 2 + (c >> 5), rr = r & 15, cc = c & 31, ob = rr * 64 + cc * 2; return st * 1024 + (ob ^ (((ob >> 9) & 1) << 5)); }
__host__ __device__ __forceinline__ void stage_rc(int b, int& R, int& C) { const int st = b / 1024, sb = b % 1024, swz = sb ^ (((sb >> 9) & 1) << 5); R = (st >> 1) * 16 + swz / 64; C = (st & 1) * 32 + (swz % 64) / 2; }
__host__ __device__ __forceinline__ int perm32(int rho) { const int n = rho >> 4, i = rho & 15; return 8 * (i >> 2) + 4 * n + (i & 3); }

struct Unit { int pm, pn; };
struct Gemm { const bf16_t* A; const bf16_t* Bt; int M, N, K; };

struct StaticOrder {
    int nM, nN, nwg, G, c;
    __host__ __device__ void init(int M, int N, int G_, int c_) { nM = M / BM; nN = N / BM; nwg = nM * nN; G = G_; c = c_; }
    __host__ __device__ bool next(int i, Unit& u) const {
        const long L = (long)i * G + c; if (L >= nwg) return false;
        int wgid = (int)L; { const int q = nwg / NXCD, r = nwg % NXCD, xcd = wgid % NXCD, off = wgid / NXCD; wgid = (xcd < r ? xcd * (q + 1) : r * (q + 1) + (xcd - r) * q) + off; }
        const int nig = WGM * nN, gid = wgid / nig, fm = gid * WGM, gsz = (nM - fm) < WGM ? (nM - fm) : WGM;
        u.pm = fm + ((wgid % nig) % gsz); u.pn = (wgid % nig) / gsz; return true;
    }
    __device__ __forceinline__ void a_ready(const Unit&) const {}
    __device__ __forceinline__ void done(const Unit&) const {}
};

__device__ __forceinline__ unsigned cvt_pk_bf16(float lo, float hi) { unsigned r; asm volatile("v_cvt_pk_bf16_f32 %0, %1, %2" : "=v"(r) : "v"(lo), "v"(hi)); return r; }
typedef float f32x2 __attribute__((ext_vector_type(2)));
typedef unsigned u32x2 __attribute__((ext_vector_type(2)));
enum { EM_ATT_QK = 0, EM_ATT_VT = 1, EM_RELU2 = 2, EM_GLA_QKG = 3, EM_GLA_VT = 4 };
struct EpiB {
    static constexpr bool PERM = true, AFTER_DRAIN = false;
    int mode; bf16_t* p0; bf16_t* p1; float scale0;
    __device__ __forceinline__ void operator()(const f32x4 (&acc)[2][2][4][2], const Unit& u, int wr, int wc, int fr, int fq) const {
        const int row0 = u.pm * BM + wr * 64 + fr; const int colt = u.pn * BM; const int cl = wc * 32 + 8 * fq;
        float sc = 1.f; if (mode == EM_ATT_QK && colt < 1024) sc = scale0;
#pragma unroll
        for (int ai = 0; ai < 2; ++ai)
#pragma unroll
            for (int m = 0; m < 4; ++m) {
                const int row = row0 + ai * HALF + m * 16;
#pragma unroll
                for (int bj = 0; bj < 2; ++bj) {
                    const int col = colt + cl + bj * HALF;
                    f32x4 v0 = acc[ai][bj][m][0], v1 = acc[ai][bj][m][1];
                    bf16_t* dst;
                    if (mode == EM_ATT_QK) {
                        if (colt < 1024) dst = p0 + (size_t)row * 1024 + col;
                        else { const int kc = col - 1024, h = kc >> 7, ch = (kc & 127) >> 3, b = row >> 12, t = row & 4095;
                               dst = p1 + ((((size_t)(b * 8 + h) * 64 + (t >> 6)) * 16 + ch) * 64 + (t & 63)) * 8; }
                    } else if (mode == EM_ATT_VT) {
                        const int h = row >> 7, d = row & 127, b = col >> 12, t = col & 4095;
                        dst = p0 + ((((size_t)(b * 8 + h) * 64 + (t >> 6)) * 8 + ((t & 63) >> 3)) * 128 + d) * 8;
                    } else if (mode == EM_RELU2) {
                        v0 = __builtin_elementwise_max(v0, (f32x4){0.f, 0.f, 0.f, 0.f}); v1 = __builtin_elementwise_max(v1, (f32x4){0.f, 0.f, 0.f, 0.f});
                        v0 = v0 * v0; v1 = v1 * v1;
                        dst = p0 + (size_t)row * 4096 + col;
                    } else if (mode == EM_GLA_QKG) {
                        dst = (colt < 1024) ? p0 + (size_t)row * 1024 + col : p1 + (size_t)row * 1024 + (col - 1024);
                    } else {
                        const int h = row >> 8, dv = row & 255, b = col >> 12, t = col & 4095;
                        dst = p0 + ((((size_t)(b * 4 + h) * 64 + (t >> 6)) * 8 + ((t & 63) >> 3)) * 256 + dv) * 8;
                    }
                    v0 = v0 * sc; v1 = v1 * sc;
                    u32x4 w; w.x = cvt_pk_bf16(v0[0], v0[1]); w.y = cvt_pk_bf16(v0[2], v0[3]); w.z = cvt_pk_bf16(v1[0], v1[1]); w.w = cvt_pk_bf16(v1[2], v1[3]);
                    *(u32x4*)dst = w;
                }
            }
    }
};
struct EpiRes {
    static constexpr bool PERM = false, AFTER_DRAIN = false;
    const float* base; float* out;
    __device__ __forceinline__ void operator()(const f32x4 (&acc)[2][2][4][2], const Unit& u, int wr, int wc, int fr, int fq) const {
        const int row0 = u.pm * BM + wr * 64 + fr; const int col0 = u.pn * BM + wc * 32 + 4 * fq;
#pragma unroll
        for (int ai = 0; ai < 2; ++ai) {
            f32x4 bs[4][2][2];
#pragma unroll
            for (int m = 0; m < 4; ++m) { const size_t off = (size_t)(row0 + ai * HALF + m * 16) * 1024 + col0;
#pragma unroll
                for (int bj = 0; bj < 2; ++bj)
#pragma unroll
                    for (int n = 0; n < 2; ++n) bs[m][bj][n] = *(const f32x4*)(base + off + bj * HALF + n * 16); }
#pragma unroll
            for (int m = 0; m < 4; ++m) { const size_t off = (size_t)(row0 + ai * HALF + m * 16) * 1024 + col0;
#pragma unroll
                for (int bj = 0; bj < 2; ++bj)
#pragma unroll
                    for (int n = 0; n < 2; ++n) *(f32x4*)(out + off + bj * HALF + n * 16) = bs[m][bj][n] + acc[ai][bj][m][n]; }
        }
    }
};
template <class Epi, class Sched, bool ALIGN_EPI = false, bool SP2 = false>
__device__ __forceinline__ void gemm_phase(PG8_LAS unsigned char* lds, const Gemm g, const Sched& S, const Epi& E) {
    const int tid = opaque_tid(), wid = __builtin_amdgcn_readfirstlane(tid >> 6), lane = tid & 63, wr = wid >> 2, wc = wid & 3, fr = lane & 15, fq = lane >> 4;
    const int K = g.K, nt = K / BK;
    unsigned voffA[2], voffB[2];
#pragma unroll
    for (int i = 0; i < 2; ++i) { int R, C; stage_rc(tid * 16 + i * 8192, R, C); const int Rb = Epi::PERM ? ((R & ~31) + perm32(R & 31)) : R;
        voffA[i] = (unsigned)(R * K + C) * 2u; voffB[i] = (unsigned)(Rb * K + C) * 2u; }
    const size_t kstep = (size_t)(BK * 2);
    const size_t hstep = (size_t)HALF * K * 2;
    const size_t tstep = 2 * hstep;
    const unsigned ldsw = (unsigned)wid * 1024u;
    const int aoff = lds_byte(wr * 64 + fr, fq * 8), boff = lds_byte(wc * 32 + fr, fq * 8);
#define PG8_SA(b, h) (((b) * 2 + (h)) * HTB)
#define PG8_SB(b, h) ((4 + (b) * 2 + (h)) * HTB)
#define PG8_STAGE(bufoff, gbase, voff) do { _Pragma("unroll") for (int _i = 0; _i < 2; ++_i) \
        __builtin_amdgcn_global_load_lds((const unsigned*)((const char*)(gbase) + (voff)[_i]), (PG8_LAS unsigned*)(lds + (bufoff) + ldsw + _i * 8192), 16, 0, 0); } while (0)
#define PG8_LDA(dst, b, h) do { _Pragma("unroll") for (int m = 0; m < 4; ++m) _Pragma("unroll") for (int k = 0; k < 2; ++k) dst[m][k] = *(const PG8_LAS bf16x8*)(lds + PG8_SA(b, h) + aoff + m * 2048 + k * 1024); } while (0)
#define PG8_LDB(dst, b, h) do { _Pragma("unroll") for (int n = 0; n < 2; ++n) _Pragma("unroll") for (int k = 0; k < 2; ++k) dst[n][k] = *(const PG8_LAS bf16x8*)(lds + PG8_SB(b, h) + boff + n * 2048 + k * 1024); } while (0)
#define PG8_MMA(ai, bj, At, Bt) do { __builtin_amdgcn_s_setprio(1); _Pragma("unroll") for (int m = 0; m < 4; ++m) _Pragma("unroll") for (int n = 0; n < 2; ++n) _Pragma("unroll") for (int k = 0; k < 2; ++k) \
        acc[ai][bj][m][n] = __builtin_amdgcn_mfma_f32_16x16x32_bf16(Bt[n][k], At[m][k], acc[ai][bj][m][n], 0, 0, 0); __builtin_amdgcn_s_setprio(0); } while (0)
#define PG8_WAIT_V(n) asm volatile("s_waitcnt vmcnt(" #n ")" ::: "memory")
#define PG8_WAIT_L(n) asm volatile("s_waitcnt lgkmcnt(" #n ")" ::: "memory")
#define PG8_BAR __builtin_amdgcn_s_barrier()
#define PG8_SCHED __builtin_amdgcn_sched_barrier(0)
    Unit cur, nxt; int ui = 0;
    if (!S.next(0, cur)) return;
    f32x4 acc[2][2][4][2];
#pragma unroll
    for (int a = 0; a < 2; ++a)
#pragma unroll
        for (int b = 0; b < 2; ++b)
#pragma unroll
            for (int m = 0; m < 4; ++m)
#pragma unroll
                for (int n = 0; n < 2; ++n) acc[a][b][m][n] = (f32x4){0.f, 0.f, 0.f, 0.f};
    bf16x8 At[4][2], B0[2][2], B1[2][2];
    const char* cA = (const char*)g.A + (size_t)cur.pm * tstep; const char* cB = (const char*)g.Bt + (size_t)cur.pn * tstep;
    S.a_ready(cur);
    if constexpr (SP2) {
        PG8_STAGE(PG8_SB(0, 0), cB, voffB); PG8_STAGE(PG8_SB(0, 1), cB + hstep, voffB); PG8_STAGE(PG8_SA(0, 0), cA, voffA); PG8_STAGE(PG8_SA(0, 1), cA + hstep, voffA);
        if (wr == 1) PG8_BAR;
        PG8_WAIT_V(2); PG8_BAR;
        PG8_STAGE(PG8_SB(1, 0), cB + kstep, voffB); PG8_STAGE(PG8_SA(1, 0), cA + kstep, voffA); PG8_STAGE(PG8_SB(1, 1), cB + hstep + kstep, voffB);
        PG8_WAIT_V(6); PG8_BAR;
    } else {
        PG8_STAGE(PG8_SB(0, 0), cB, voffB); PG8_STAGE(PG8_SA(0, 0), cA, voffA); PG8_STAGE(PG8_SB(0, 1), cB + hstep, voffB); PG8_STAGE(PG8_SA(0, 1), cA + hstep, voffA);
        if (wr == 1) PG8_BAR;
        PG8_WAIT_V(4); PG8_BAR;
        PG8_STAGE(PG8_SB(1, 0), cB + kstep, voffB); PG8_STAGE(PG8_SA(1, 0), cA + kstep, voffA); PG8_STAGE(PG8_SB(1, 1), cB + hstep + kstep, voffB);
        PG8_WAIT_V(6); PG8_BAR;
    }
    for (;;) {
        const bool has_next = S.next(ui + 1, nxt);
        const char* nA = has_next ? (const char*)g.A + (size_t)nxt.pm * tstep : cA; const char* nB = has_next ? (const char*)g.Bt + (size_t)nxt.pn * tstep : cB;
        for (int t = 0; t < nt; t += 2) {
            const bool last = (t == nt - 2);
            const char* a1 = cA + (size_t)(t + 1) * kstep;
            const char* a2 = last ? nA : cA + (size_t)(t + 2) * kstep; const char* b2 = last ? nB : cB + (size_t)(t + 2) * kstep;
            const char* a3 = a2 + kstep; const char* b3 = b2 + kstep;
            if (last && has_next) S.a_ready(nxt);
            if constexpr (SP2) {
            PG8_LDB(B0, 0, 0); PG8_LDB(B1, 0, 1); PG8_SCHED; PG8_LDA(At, 0, 0); PG8_STAGE(PG8_SA(1, 1), a1 + hstep, voffA);
            PG8_WAIT_V(8); PG8_WAIT_L(0); PG8_BAR; PG8_MMA(0, 0, At, B0); PG8_MMA(0, 1, At, B1); PG8_BAR; PG8_SCHED;
            PG8_LDA(At, 0, 1); PG8_STAGE(PG8_SB(0, 0), b2, voffB); PG8_STAGE(PG8_SB(0, 1), b2 + hstep, voffB); PG8_STAGE(PG8_SA(0, 0), a2, voffA);
            PG8_WAIT_V(8); PG8_WAIT_L(0); PG8_BAR; PG8_MMA(1, 0, At, B0); PG8_MMA(1, 1, At, B1); PG8_BAR; PG8_SCHED;
            PG8_LDB(B0, 1, 0); PG8_LDB(B1, 1, 1); PG8_SCHED; PG8_LDA(At, 1, 0); PG8_STAGE(PG8_SA(0, 1), a2 + hstep, voffA);
            PG8_WAIT_V(8); PG8_WAIT_L(0); PG8_BAR; PG8_MMA(0, 0, At, B0); PG8_MMA(0, 1, At, B1); PG8_BAR; PG8_SCHED;
            PG8_LDA(At, 1, 1); PG8_STAGE(PG8_SB(1, 0), b3, voffB); PG8_STAGE(PG8_SB(1, 1), b3 + hstep, voffB); PG8_STAGE(PG8_SA(1, 0), a3, voffA);
            PG8_WAIT_V(8); PG8_WAIT_L(0); PG8_BAR; PG8_MMA(1, 0, At, B0); PG8_MMA(1, 1, At, B1); PG8_BAR; PG8_SCHED;
            } else {
            PG8_LDB(B0, 0, 0); PG8_SCHED; PG8_LDA(At, 0, 0); PG8_STAGE(PG8_SA(1, 1), a1 + hstep, voffA);
            PG8_WAIT_L(8); PG8_BAR; PG8_WAIT_L(0); PG8_MMA(0, 0, At, B0); PG8_BAR; PG8_SCHED;
            PG8_LDB(B1, 0, 1); PG8_STAGE(PG8_SB(0, 0), b2, voffB);
            PG8_BAR; PG8_WAIT_L(0); PG8_MMA(0, 1, At, B1); PG8_BAR;
            PG8_LDA(At, 0, 1); PG8_STAGE(PG8_SA(0, 0), a2, voffA);
            PG8_BAR; PG8_WAIT_L(0); PG8_MMA(1, 0, At, B0); PG8_BAR; PG8_SCHED;
            PG8_STAGE(PG8_SB(0, 1), b2 + hstep, voffB);
            PG8_WAIT_V(6); PG8_BAR; PG8_MMA(1, 1, At, B1); PG8_BAR;
            PG8_LDB(B0, 1, 0); PG8_SCHED; PG8_LDA(At, 1, 0); PG8_STAGE(PG8_SA(0, 1), a2 + hstep, voffA);
            PG8_WAIT_L(8); PG8_BAR; PG8_WAIT_L(0); PG8_MMA(0, 0, At, B0); PG8_BAR; PG8_SCHED;
            PG8_LDB(B1, 1, 1); PG8_STAGE(PG8_SB(1, 0), b3, voffB);
            PG8_BAR; PG8_WAIT_L(0); PG8_MMA(0, 1, At, B1); PG8_BAR;
            PG8_LDA(At, 1, 1); PG8_STAGE(PG8_SA(1, 0), a3, voffA);
            PG8_BAR; PG8_WAIT_L(0); PG8_MMA(1, 0, At, B0); PG8_BAR; PG8_SCHED;
            PG8_STAGE(PG8_SB(1, 1), b3 + hstep, voffB);
            PG8_WAIT_V(6); PG8_BAR; PG8_MMA(1, 1, At, B1); PG8_BAR;
            }
        }
        if constexpr (ALIGN_EPI) { if (wr == 0) PG8_BAR; }
        if constexpr (!Epi::AFTER_DRAIN) { E(acc, cur, wr, wc, fr, fq); S.done(cur); }
        if (!has_next) break;
#pragma unroll
        for (int a = 0; a < 2; ++a)
#pragma unroll
            for (int b = 0; b < 2; ++b)
#pragma unroll
                for (int m = 0; m < 4; ++m)
#pragma unroll
                    for (int n = 0; n < 2; ++n) acc[a][b][m][n] = (f32x4){0.f, 0.f, 0.f, 0.f};
        cur = nxt; cA = nA; cB = nB; ++ui;
        if constexpr (ALIGN_EPI) { if (wr == 1) PG8_BAR; }
    }
    PG8_WAIT_V(0);
    if constexpr (!ALIGN_EPI) { if (wr == 0) PG8_BAR; }
    PG8_BAR;
    if constexpr (Epi::AFTER_DRAIN) { E.fused(acc, cur, wr, wc, fr, fq, lds, wid, lane); S.done(cur); }
#undef PG8_SA
#undef PG8_SB
#undef PG8_STAGE
#undef PG8_LDA
#undef PG8_LDB
#undef PG8_MMA
#undef PG8_WAIT_V
#undef PG8_WAIT_L
#undef PG8_BAR
#undef PG8_SCHED
}
}

#define LAS __attribute__((address_space(3)))
typedef unsigned short bf16_t;
typedef short bf16x8 __attribute__((ext_vector_type(8)));
typedef float f32x4 __attribute__((ext_vector_type(4)));
typedef float f32x16 __attribute__((ext_vector_type(16)));
typedef unsigned u32x4 __attribute__((ext_vector_type(4)));
typedef unsigned u32x2 __attribute__((ext_vector_type(2)));

constexpr int NWAVES = 8, NTHR = 512;
constexpr int DM = 1024, NB = 8, SEQ = 4096, MR = NB * SEQ  , NMETA = 16, MT = MR + NMETA, FF = 4096;
constexpr float EPS = 1e-6f;
constexpr float LOG2E = 1.4426950408889634f;
constexpr float QSCALE = 0.125f * LOG2E;
constexpr int LDS_BAR_OFF = 153600;
constexpr int LDS_BYTES = 153856;

constexpr size_t MiB = 1u << 20;
constexpr size_t WS_CTL = 0;
constexpr size_t WS_WQKV = 1 * MiB, WS_WQKV_STRIDE = 6 * MiB;
constexpr size_t WS_WAO = 13 * MiB, WS_WAO_STRIDE = 2 * MiB;
constexpr size_t WS_WGLA = 17 * MiB, WS_WGLA_STRIDE = 7 * MiB;
constexpr size_t WS_WGO = 31 * MiB, WS_WGO_STRIDE = 2 * MiB;
constexpr size_t WS_WUP = 35 * MiB, WS_WUP_STRIDE = 8 * MiB;
constexpr size_t WS_WDN = 67 * MiB, WS_WDN_STRIDE = 8 * MiB;
constexpr size_t WS_HMETA = 99 * MiB;
constexpr size_t WS_HN = 100 * MiB;
constexpr size_t WS_BIG = 166 * MiB;
constexpr size_t AB_Q = WS_BIG, AB_KIMG = WS_BIG + 65 * MiB, AB_VIMG = WS_BIG + 129 * MiB, AB_KMETA = WS_BIG + 193 * MiB, AB_VMETA = AB_KMETA + 131072;
constexpr size_t KiB64 = 65536;
constexpr size_t GB_QK = WS_BIG, GB_G = GB_QK + 1025 * KiB64, GB_VT = GB_G + 1025 * KiB64, GB_VTMETA = GB_VT + 1024 * KiB64, GB_GZ = GB_VTMETA + 2 * KiB64,
                 GB_QP = GB_GZ + 33 * KiB64, GB_KT = GB_QP + 514 * KiB64, GB_A = GB_KT + 514 * KiB64, GB_DEC = GB_A + 257 * KiB64, GB_ORAW = GB_DEC + 33 * KiB64,
                 GB_END = GB_ORAW + 1027 * KiB64;
constexpr size_t MB_U = WS_BIG;
constexpr size_t WS_END = GB_END;
static_assert(GB_END <= 512 * MiB && MB_U + (size_t)MT * FF * 2 <= GB_END && AB_VMETA + 131072 <= GB_END, "workspace map");

__device__ __forceinline__ float wave_sum(float v) {
#pragma unroll
    for (int o = 1; o < 64; o <<= 1) v += __shfl_xor(v, o);
    return v;
}
typedef float f32x2_t __attribute__((ext_vector_type(2))); typedef __bf16 bf16x2_t __attribute__((ext_vector_type(2)));
__device__ __forceinline__ unsigned pk_bf16(float lo, float hi) { f32x2_t v = {lo, hi}; bf16x2_t b = __builtin_convertvector(v, bf16x2_t); return __builtin_bit_cast(unsigned, b); }
__device__ __forceinline__ float bf2f(bf16_t v) { return __uint_as_float((unsigned)v << 16); }
__device__ __forceinline__ bf16_t f2bf(float f) { return (bf16_t)(pk_bf16(f, 0.f) & 0xffffu); }
__device__ __forceinline__ float fexp2(float x) { return __builtin_amdgcn_exp2f(x); }

__device__ __forceinline__ void p0_transpose_item(const float* W, int ldw, int K, bf16_t* WT, int k0, int n0, int orow0, LAS float* scr, int lane) {
#pragma unroll 8
    for (int i = 0; i < 32; ++i) { const int kk = 2 * i + (lane >> 5); scr[kk * 33 + (lane & 31)] = W[(size_t)(k0 + kk) * ldw + n0 + (lane & 31)]; }
    asm volatile("s_waitcnt lgkmcnt(0)" ::: "memory");
    const int c = lane & 7;
#pragma unroll
    for (int j = 0; j < 4; ++j) { const int n = (lane >> 3) + 8 * j; const LAS float* s = scr + (8 * c) * 33 + n;
        u32x4 o; o.x = pk_bf16(s[0 * 33], s[1 * 33]); o.y = pk_bf16(s[2 * 33], s[3 * 33]); o.z = pk_bf16(s[4 * 33], s[5 * 33]); o.w = pk_bf16(s[6 * 33], s[7 * 33]);
        *(u32x4*)(WT + (size_t)(orow0 + n) * K + k0 + 8 * c) = o; }
    asm volatile("s_waitcnt lgkmcnt(0)" ::: "memory");
}

struct Ptrs {
    const float *x, *meta, *mix_w, *attn_w_in, *attn_lam, *attn_subln, *attn_w_out, *gla_w_in, *gla_w_gate, *gla_bias, *gla_norm, *gla_w_out, *mlp_norm, *mlp_up, *mlp_dn, *final_w;
    float* out; unsigned char* ws;
};

typedef const __attribute__((address_space(4))) Ptrs* KP;
__device__ __forceinline__ void p0_prologue(KP P, LAS unsigned char* lds, int G) {
    const int tid = opaque_tid(), lane = tid & 63, wid = __builtin_amdgcn_readfirstlane(tid >> 6);
    LAS float* scr = (LAS float*)(lds + wid * 16384);
    const int gw = blockIdx.x * NWAVES + wid, NGW = G * NWAVES;
    constexpr int I_AIN = 16 * 96, I_AO = 16 * 32, I_GIN = 16 * 96, I_GO = 16 * 32, I_UP = 16 * 128, I_DN = 64 * 32;
    constexpr int NITEMS = 2 * I_AIN + 2 * I_AO + 2 * I_GIN + 2 * I_GO + 4 * I_UP + 4 * I_DN;
    for (int it = gw; it < NITEMS; it += NGW) {
        int r = it;
        if (r < 2 * I_AIN) { const int j = r / I_AIN; r -= j * I_AIN; const int kb = r / 96, nb = r % 96;
            p0_transpose_item(P->attn_w_in + (size_t)j * 1024 * 3072, 3072, 1024, (bf16_t*)(P->ws + WS_WQKV + j * WS_WQKV_STRIDE), 64 * kb, 32 * nb, 32 * nb, scr, lane); continue; }
        r -= 2 * I_AIN;
        if (r < 2 * I_AO) { const int j = r / I_AO; r -= j * I_AO; const int kb = r / 32, nb = r % 32;
            p0_transpose_item(P->attn_w_out + (size_t)j * 1024 * 1024, 1024, 1024, (bf16_t*)(P->ws + WS_WAO + j * WS_WAO_STRIDE), 64 * kb, 32 * nb, 32 * nb, scr, lane); continue; }
        r -= 2 * I_AO;
        if (r < 2 * I_GIN) { const int j = r / I_GIN; r -= j * I_GIN; const int kb = r / 96, nb = r % 96; const int n0 = 32 * nb;
            const int orow = n0 < 1024 ? n0 : (n0 < 2048 ? n0 + 1024 : n0 - 1024);
            p0_transpose_item(P->gla_w_in + (size_t)j * 1024 * 3088, 3088, 1024, (bf16_t*)(P->ws + WS_WGLA + j * WS_WGLA_STRIDE), 64 * kb, n0, orow, scr, lane); continue; }
        r -= 2 * I_GIN;
        if (r < 2 * I_GO) { const int j = r / I_GO; r -= j * I_GO; const int kb = r / 32, nb = r % 32;
            p0_transpose_item(P->gla_w_out + (size_t)j * 1024 * 1024, 1024, 1024, (bf16_t*)(P->ws + WS_WGO + j * WS_WGO_STRIDE), 64 * kb, 32 * nb, 32 * nb, scr, lane); continue; }
        r -= 2 * I_GO;
        if (r < 4 * I_UP) { const int j = r / I_UP; r -= j * I_UP; const int kb = r / 128, nb = r % 128;
            p0_transpose_item(P->mlp_up + (size_t)j * 1024 * 4096, 4096, 1024, (bf16_t*)(P->ws + WS_WUP + j * WS_WUP_STRIDE), 64 * kb, 32 * nb, 32 * nb, scr, lane); continue; }
        r -= 4 * I_UP;
        { const int j = r / I_DN; r -= j * I_DN; const int kb = r / 32, nb = r % 32;
            p0_transpose_item(P->mlp_dn + (size_t)j * 4096 * 1024, 1024, 4096, (bf16_t*)(P->ws + WS_WDN + j * WS_WDN_STRIDE), 64 * kb, 32 * nb, 32 * nb, scr, lane); }
    }
    const int gt = blockIdx.x * NTHR + tid, NGT = G * NTHR;
    for (int e = gt; e < 2 * 16 * 1024; e += NGT) { const int j = e >> 14, rr = (e >> 10) & 15, k = e & 1023;
        ((bf16_t*)(P->ws + WS_WGLA + j * WS_WGLA_STRIDE))[(size_t)(3072 + rr) * 1024 + k] = f2bf(P->gla_w_in[(size_t)j * 1024 * 3088 + (size_t)k * 3088 + 3072 + rr]); }
}

__device__ __forceinline__ void norm_phase(const float* src_real, const float* src_meta, const float* w, bf16_t* hn, int G) {
    const int tid = opaque_tid(), lane = tid & 63, wid = __builtin_amdgcn_readfirstlane(tid >> 6);
    const int gw = blockIdx.x * NWAVES + wid, NGW = G * NWAVES;
    f32x4 wv[4];
#pragma unroll
    for (int j = 0; j < 4; ++j) wv[j] = ((const f32x4*)w)[lane + 64 * j];
    for (int row = gw; row < MT; row += NGW) {
        const float* xr = row < MR ? src_real + (size_t)row * DM : src_meta + (size_t)(row - MR) * DM;
        f32x4 v[4]; float s = 0.f;
#pragma unroll
        for (int j = 0; j < 4; ++j) { v[j] = ((const f32x4*)xr)[lane + 64 * j]; s += (v[j].x * v[j].x + v[j].y * v[j].y) + (v[j].z * v[j].z + v[j].w * v[j].w); }
        const float r = rsqrtf(wave_sum(s) * (1.f / DM) + EPS);
        u32x2* o8 = (u32x2*)(hn + (size_t)row * DM) + lane;
#pragma unroll
        for (int j = 0; j < 4; ++j) { u32x2 o; o.x = pk_bf16(v[j].x * r * wv[j].x, v[j].y * r * wv[j].y); o.y = pk_bf16(v[j].z * r * wv[j].z, v[j].w * r * wv[j].w); o8[64 * j] = o; }
    }
}
__device__ __forceinline__ void final_norm_phase(float* h, const float* w, int G) {
    const int tid = opaque_tid(), lane = tid & 63, wid = __builtin_amdgcn_readfirstlane(tid >> 6);
    const int gw = blockIdx.x * NWAVES + wid, NGW = G * NWAVES;
    f32x4 wv[4];
#pragma unroll
    for (int j = 0; j < 4; ++j) wv[j] = ((const f32x4*)w)[lane + 64 * j];
    for (int row = gw; row < MR; row += NGW) {
        f32x4* xr = (f32x4*)(h + (size_t)row * DM);
        f32x4 v[4]; float s = 0.f;
#pragma unroll
        for (int j = 0; j < 4; ++j) { v[j] = xr[lane + 64 * j]; s += (v[j].x * v[j].x + v[j].y * v[j].y) + (v[j].z * v[j].z + v[j].w * v[j].w); }
        const float r = rsqrtf(wave_sum(s) * (1.f / DM) + EPS);
#pragma unroll
        for (int j = 0; j < 4; ++j) xr[lane + 64 * j] = v[j] * r * wv[j];
    }
}

enum { MM_ATT = 0, MM_RES = 1, MM_RELU2 = 2, MM_GLA = 3, MM_GZ = 4 };
struct MiniEpi { int mode; void* p0; void* p1; void* p2; const float* base; };
__device__ __forceinline__ void mini_store(const MiniEpi& E, int row, int n, float v) {
    if (E.mode == MM_ATT) {
        if (n < 1024) ((bf16_t*)E.p0)[(size_t)(MR + row) * 1024 + n] = f2bf(v * QSCALE);
        else if (n < 2048) { const int kc = n - 1024, h = kc >> 7, ch = (kc & 127) >> 3; ((bf16_t*)E.p1)[((size_t)(h * 16 + ch) * 64 + row) * 8 + (kc & 7)] = f2bf(v); }
        else { const int vc = n - 2048, h = vc >> 7, d = vc & 127; ((bf16_t*)E.p2)[((size_t)(h * 8 + (row >> 3)) * 128 + d) * 8 + (row & 7)] = f2bf(v); }
    } else if (E.mode == MM_RES) {
        ((float*)E.p0)[(size_t)row * 1024 + n] = E.base[(size_t)row * 1024 + n] + v;
    } else if (E.mode == MM_RELU2) {
        const float r = fmaxf(v, 0.f); ((bf16_t*)E.p0)[(size_t)(MR + row) * 4096 + n] = f2bf(r * r);
    } else if (E.mode == MM_GLA) {
        if (n < 1024) ((bf16_t*)E.p0)[(size_t)(MR + row) * 1024 + n] = f2bf(v);
        else if (n < 2048) ((bf16_t*)E.p1)[(size_t)(MR + row) * 1024 + (n - 1024)] = f2bf(v);
        else { const int vc = n - 2048, h = vc >> 8, dv = vc & 255; ((bf16_t*)E.p2)[((size_t)(h * 8 + (row >> 3)) * 256 + dv) * 8 + (row & 7)] = f2bf(v); }
    } else {
        ((float*)E.p0)[(size_t)n * 16 + row] = v;
    }
}
__device__ __forceinline__ void mini_gemm(LAS unsigned char* lds, const bf16_t* A16, const bf16_t* Bt, int N, int K, const MiniEpi& E, int G) {
    const int tid = opaque_tid(), lane = tid & 63, wid = __builtin_amdgcn_readfirstlane(tid >> 6);
    LAS float* part = (LAS float*)lds;
    const int kw = K / 8, k0 = wid * kw;
    for (int task = blockIdx.x; task < N / 16; task += G) {
        const bf16_t* ap = A16 + (size_t)(lane & 15) * K + k0 + (lane >> 4) * 8;
        const bf16_t* bp = Bt + (size_t)(task * 16 + (lane & 15)) * K + k0 + (lane >> 4) * 8;
        f32x4 acc = {0.f, 0.f, 0.f, 0.f};
#pragma unroll 4
        for (int k = 0; k < kw; k += 32) { const bf16x8 a = *(const bf16x8*)(ap + k); const bf16x8 b = *(const bf16x8*)(bp + k); acc = __builtin_amdgcn_mfma_f32_16x16x32_bf16(a, b, acc, 0, 0, 0); }
#pragma unroll
        for (int j = 0; j < 4; ++j) part[wid * 256 + ((lane >> 4) * 4 + j) * 16 + (lane & 15)] = acc[j];
        __syncthreads();
        if (tid < 256) { float s = 0.f;
#pragma unroll
            for (int w = 0; w < 8; ++w) s += part[w * 256 + tid];
            mini_store(E, tid >> 4, task * 16 + (tid & 15), s); }
        __syncthreads();
    }
}

__device__ __forceinline__ void gz_gemm(const bf16_t* Wz  , const bf16_t* hn  , float* gz, int G) {
    const int tid = opaque_tid(), lane = tid & 63, wid = __builtin_amdgcn_readfirstlane(tid >> 6);
    for (int task = blockIdx.x * NWAVES + wid; task < MT / 16; task += G * NWAVES) {
        const bf16_t* ap = Wz + (size_t)(lane & 15) * DM + (lane >> 4) * 8;
        const bf16_t* bp = hn + (size_t)(task * 16 + (lane & 15)) * DM + (lane >> 4) * 8;
        f32x4 acc0 = {0.f, 0.f, 0.f, 0.f}, acc1 = {0.f, 0.f, 0.f, 0.f};
#pragma unroll 8
        for (int k = 0; k < DM; k += 64) {
            const bf16x8 a0 = *(const bf16x8*)(ap + k), b0 = *(const bf16x8*)(bp + k), a1 = *(const bf16x8*)(ap + k + 32), b1 = *(const bf16x8*)(bp + k + 32);
            acc0 = __builtin_amdgcn_mfma_f32_16x16x32_bf16(a0, b0, acc0, 0, 0, 0); acc1 = __builtin_amdgcn_mfma_f32_16x16x32_bf16(a1, b1, acc1, 0, 0, 0); }
        const f32x4 r = acc0 + acc1;
        *(f32x4*)(gz + (size_t)(task * 16 + (lane & 15)) * 16 + (lane >> 4) * 4) = r;
    }
}

__device__ __forceinline__ void glds16(const void* gsrc, unsigned lds_dst) { unsigned keep;
    asm volatile("s_mov_b32 %0, m0\n\ts_mov_b32 m0, %2\n\ts_nop 0\n\tglobal_load_lds_dwordx4 %1, off\n\ts_mov_b32 m0, %0" : "=&s"(keep) : "v"(gsrc), "s"(lds_dst) : "memory"); }
__device__ __forceinline__ float max3f(float a, float b, float c) { float r; asm("v_max3_f32 %0, %1, %2, %3" : "=v"(r) : "v"(a), "v"(b), "v"(c)); return r; }
#define WAITV_BAR(N) asm volatile("s_waitcnt vmcnt(" #N ") lgkmcnt(0)\n\ts_barrier" ::: "memory")
__device__ __forceinline__ float half_max(float v) { const unsigned u = __float_as_uint(v); auto rr = __builtin_amdgcn_permlane32_swap(u, u, false, false);
    return fmaxf(__uint_as_float(rr[0]), __uint_as_float(rr[1])); }
__device__ __forceinline__ int kvperm(int i) { const int r = 4 * (i >> 3) + (i & 3), hh = (i >> 2) & 1; return 16 * (r >> 3) + 8 * hh + (r & 7); }

__device__ __forceinline__ void attn_phase(LAS unsigned char* lds, const bf16_t* Q, const bf16_t* Kimg, const bf16_t* Vimg, const bf16_t* Kmeta, const bf16_t* Vmeta,
                                           bf16_t* O, const float* lamp, const float* sublnw, float lambda_init, int G) {
    const int tid = opaque_tid(), lane = tid & 63, wid = __builtin_amdgcn_readfirstlane(tid >> 6), l31 = lane & 31, hi = lane >> 5;
    const int qg = wid & 3, c = wid >> 2;
    const int skew = (wid ^ (wid >> 2)) & 1;
    float lam;
    { const float a = lamp[lane] * lamp[64 + lane], b2 = lamp[128 + lane] * lamp[192 + lane]; lam = __expf(wave_sum(a)) - __expf(wave_sum(b2)) + lambda_init; }
    const int kvrow = kvperm(l31);
    LAS float* exch = (LAS float*)(lds + qg * 16384);
    for (int item = blockIdx.x; item < 1024 + 8; item += G) {
        for (int half = 0; half < 2; ++half) {
            int b, h, qb; bool metaq = false;
            if (item < 1024) {
                int bh = item >> 4, s = item & 15;
                if (G == 256) {
                    const int v = item & 255, it = item >> 8, x = v & 7, t = v >> 3;
                    bh = (it >> 1) * 32 + x * 4 + (t >> 3); s = (t & 7) + 8 * (it & 1);
                }
                b = bh >> 3; h = bh & 7; qb = half ? 31 - s : s; }
            else { if (half) break; metaq = true; b = 0; h = item - 1024; qb = 0; }
            const int NT = metaq ? 1 : 2 * qb + 3;
            const bool active = !metaq || qg == 0;
            const int qpos0 = metaq ? 0 : 16 + 128 * qb;
            const int qrow = metaq ? MR + l31 : b * SEQ + 128 * qb + 32 * qg + l31;
            const int qpos = metaq ? l31 : qpos0 + 32 * qg + l31;
            const float slope2 = exp2f(-(float)(h + 1)) * LOG2E;
            const bf16_t* Kbh = Kimg + (size_t)(b * 8 + h) * 64 * 8192; const bf16_t* Vbh = Vimg + (size_t)(b * 8 + h) * 64 * 8192;
            const bf16_t* Kmh = Kmeta + (size_t)h * 8192; const bf16_t* Vmh = Vmeta + (size_t)h * 8192;
            const unsigned ldsb = (unsigned)(uintptr_t)lds;
#define ATT_DMA_K(j) do { const char* ks_ = (const char*)((j) == 0 ? Kmh : Kbh + (size_t)((j) - 1) * 8192); \
            _Pragma("unroll") for (int i_ = 0; i_ < 2; ++i_) glds16(ks_ + i_ * 8192 + wid * 1024 + lane * 16, (unsigned)__builtin_amdgcn_readfirstlane(ldsb + ((j) & 3) * 16384 + i_ * 8192 + wid * 1024)); } while (0)
#define ATT_DMA_V(j) do { const char* vs_ = (const char*)((j) == 0 ? Vmh : Vbh + (size_t)((j) - 1) * 8192); \
            _Pragma("unroll") for (int i_ = 0; i_ < 2; ++i_) glds16(vs_ + i_ * 8192 + wid * 1024 + lane * 16, (unsigned)__builtin_amdgcn_readfirstlane(ldsb + 65536 + ((j) & 3) * 16384 + i_ * 8192 + wid * 1024)); } while (0)
#define ATT_QK(SA, SB, j_) do { const int kp0_ = ((j_) == 0) ? 0 : 16 + 64 * ((j_) - 1); const float tb_ = slope2 * (float)(kp0_ - qpos0 + 8 * hi) - mrun; \
            _Pragma("unroll") for (int r = 0; r < 16; ++r) { SA[r] = fmaf(slope2, (float)(16 * (r >> 3) + (r & 7)), tb_); SB[r] = fmaf(slope2, (float)(32 + 16 * (r >> 3) + (r & 7)), tb_); } \
            const LAS unsigned char* Kb_ = lds + ((j_) & 3) * 16384; \
            _Pragma("unroll") for (int d0 = 0; d0 < 4; ++d0) { const int chunk_ = c * 8 + 2 * d0 + hi; \
                const bf16x8 k0_ = *(const LAS bf16x8*)(Kb_ + chunk_ * 1024 + kvrow * 16); const bf16x8 k1_ = *(const LAS bf16x8*)(Kb_ + chunk_ * 1024 + (32 + kvrow) * 16); \
                SA = __builtin_amdgcn_mfma_f32_32x32x16_bf16(k0_, qf[d0], SA, 0, 0, 0); SB = __builtin_amdgcn_mfma_f32_32x32x16_bf16(k1_, qf[d0], SB, 0, 0, 0); } } while (0)
#define ATT_PV(PK, j_) do { const LAS unsigned char* Vb_ = ((j_) < 0) ? lds : lds + 65536 + ((j_) & 3) * 16384;     \
            _Pragma("unroll") for (int s4 = 0; s4 < 4; ++s4) { const bf16x8 pf_ = __builtin_bit_cast(bf16x8, PK[s4]); \
                _Pragma("unroll") for (int d = 0; d < 4; ++d) { const bf16x8 vf_ = *(const LAS bf16x8*)(Vb_ + (2 * s4 + hi) * 2048 + (32 * d + l31) * 16); \
                    o[d] = __builtin_amdgcn_mfma_f32_32x32x16_bf16(vf_, pf_, o[d], 0, 0, 0); } } } while (0)
            ATT_DMA_K(0); ATT_DMA_V(0);
            if (NT > 1) { ATT_DMA_K(1); ATT_DMA_V(1); }
            if (NT > 2) ATT_DMA_K(2);
            bf16x8 qf[4];
#pragma unroll
            for (int d0 = 0; d0 < 4; ++d0) qf[d0] = *(const bf16x8*)(Q + (size_t)qrow * 1024 + h * 128 + c * 64 + 16 * d0 + 8 * hi);
            f32x16 o[4];
#pragma unroll
            for (int d = 0; d < 4; ++d)
#pragma unroll
                for (int r = 0; r < 16; ++r) o[d][r] = 0.f;
            float mrun = 0.f, lrun = 0.f, alpha = 1.f;
            u32x4 pk[4];
#pragma unroll
            for (int s4 = 0; s4 < 4; ++s4) pk[s4] = (u32x4){0u, 0u, 0u, 0u};
            f32x16 sA, sB;
            asm volatile("" :: "v"(qf[0]), "v"(qf[1]), "v"(qf[2]), "v"(qf[3]));
            WAITV_BAR(0);
            if (active) ATT_QK(sA, sB, 0);
            for (int j = 0; j < NT; ++j) {
                if (j + 3 < NT) ATT_DMA_K(j + 3);
                if (j + 2 < NT) ATT_DMA_V(j + 2);
                if (active) {
                    if (j == 0 || j >= NT - 2) {
                        const int kpos0 = (j == 0) ? 0 : 16 + 64 * (j - 1);
                        const int lim = (j == 0) ? (metaq ? (l31 < 15 ? l31 : 15) : 15) : (qpos - kpos0);
#pragma unroll
                        for (int r = 0; r < 16; ++r) { const int kvl = 16 * (r >> 3) + (r & 7) + 8 * hi;
                            if (kvl > lim) sA[r] = -INFINITY; if (kvl + 32 > lim) sB[r] = -INFINITY; }
                    }
                    float mx = max3f(sA[0], sA[1], sA[2]);
#pragma unroll
                    for (int r = 3; r < 15; r += 2) mx = max3f(mx, sA[r], sA[r + 1]);
                    mx = max3f(mx, sA[15], sB[0]);
#pragma unroll
                    for (int r = 1; r < 15; r += 2) mx = max3f(mx, sB[r], sB[r + 1]);
                    mx = fmaxf(mx, sB[15]);
                    mx = half_max(mx);
                    alpha = 1.f;
                    if (__any(mx > 64.f)) { const float d = fmaxf(mx, 0.f); alpha = fexp2(-d); mrun += d;
#pragma unroll
                        for (int r = 0; r < 16; ++r) { sA[r] -= d; sB[r] -= d; } }
                    float ps = 0.f;
#pragma unroll
                    for (int q4 = 0; q4 < 8; ++q4) {
                        const float a0 = fexp2(sA[2 * q4]), a1 = fexp2(sA[2 * q4 + 1]), b0 = fexp2(sB[2 * q4]), b1 = fexp2(sB[2 * q4 + 1]);
                        ps += (a0 + a1) + (b0 + b1);
                        pk[q4 >> 2][q4 & 3] = pk_bf16(a0, a1); pk[2 + (q4 >> 2)][q4 & 3] = pk_bf16(b0, b1); }
                    lrun = lrun * alpha + ps;
                }
                if (skew == 1) { if (j + 3 < NT) WAITV_BAR(4); else WAITV_BAR(0); }
                if (active) {
                    const LAS unsigned char* Vb = lds + 65536 + (j & 3) * 16384;
                    const LAS unsigned char* Kb = lds + ((j + 1) & 3) * 16384;
                    bf16x8 fa[4], fb[4];
#define VFR(F, s4) _Pragma("unroll") for (int i = 0; i < 4; ++i) F[i] = *(const LAS bf16x8*)(Vb + (2 * (s4) + hi) * 2048 + (32 * i + l31) * 16)
#define KFR(F, dh) _Pragma("unroll") for (int i = 0; i < 4; ++i) F[i] = *(const LAS bf16x8*)(Kb + (c * 8 + 2 * (2 * (dh) + (i >> 1)) + hi) * 1024 + (32 * (i & 1) + kvrow) * 16)
#define PVM(F, s4) _Pragma("unroll") for (int i = 0; i < 4; ++i) o[i] = __builtin_amdgcn_mfma_f32_32x32x16_bf16(F[i], __builtin_bit_cast(bf16x8, pk[s4]), o[i], 0, 0, 0)
#define QKM(F, dh) _Pragma("unroll") for (int i = 0; i < 2; ++i) { sA = __builtin_amdgcn_mfma_f32_32x32x16_bf16(F[2 * i], qf[2 * (dh) + i], sA, 0, 0, 0); sB = __builtin_amdgcn_mfma_f32_32x32x16_bf16(F[2 * i + 1], qf[2 * (dh) + i], sB, 0, 0, 0); }
#define SBAR __builtin_amdgcn_sched_barrier(0)
                    __builtin_amdgcn_s_setprio(1);
                    VFR(fa, 0);
                    if (__any(alpha != 1.f)) {
#pragma unroll
                        for (int d = 0; d < 4; ++d)
#pragma unroll
                            for (int r = 0; r < 16; ++r) o[d][r] *= alpha;
                    }
                    SBAR; VFR(fb, 1); SBAR; PVM(fa, 0); SBAR; VFR(fa, 2); SBAR; PVM(fb, 1); SBAR; VFR(fb, 3); SBAR; PVM(fa, 2); SBAR; KFR(fa, 0); SBAR; PVM(fb, 3); SBAR; KFR(fb, 1);
                    { const int kp0_ = 16 + 64 * j; const float tb_ = slope2 * (float)(kp0_ - qpos0 + 8 * hi) - mrun;
#pragma unroll
                      for (int r = 0; r < 16; ++r) { sA[r] = fmaf(slope2, (float)(16 * (r >> 3) + (r & 7)), tb_); sB[r] = fmaf(slope2, (float)(32 + 16 * (r >> 3) + (r & 7)), tb_); } }
                    SBAR; QKM(fa, 0); SBAR; QKM(fb, 1);
                    __builtin_amdgcn_s_setprio(0);
#undef VFR
#undef KFR
#undef PVM
#undef QKM
#undef SBAR
                }
                if (skew == 0) { if (j + 3 < NT) WAITV_BAR(4); else WAITV_BAR(0); }
            }
            const float ltot = lrun + __shfl_xor(lrun, 32);
            const float inv = 1.f / ltot;
            if (c == 1 && active) {
#pragma unroll
                for (int d = 0; d < 4; ++d)
#pragma unroll
                    for (int r = 0; r < 16; ++r) exch[(d * 16 + r) * 64 + lane] = o[d][r] * inv;
            }
            __syncthreads();
            if (c == 0 && active) {
                float ss = 0.f;
#pragma unroll
                for (int d = 0; d < 4; ++d)
#pragma unroll
                    for (int r = 0; r < 16; ++r) { const float v = o[d][r] * inv - lam * exch[(d * 16 + r) * 64 + lane]; o[d][r] = v; ss += v * v; }
                ss += __shfl_xor(ss, 32);
                const float rn = rsqrtf(ss * (1.f / 128.f) + EPS) * (1.f - lambda_init);
                f32x4 w4s[4][4];
#pragma unroll
                for (int d = 0; d < 4; ++d)
#pragma unroll
                    for (int g4 = 0; g4 < 4; ++g4) w4s[d][g4] = *(const f32x4*)(sublnw + 32 * d + 8 * g4 + 4 * hi);
                if (!metaq || l31 < 16) {
                    bf16_t* orow = O + (size_t)qrow * 1024 + h * 128;
#pragma unroll
                    for (int d = 0; d < 4; ++d)
#pragma unroll
                        for (int g4 = 0; g4 < 4; ++g4) {
                            const int dd = 32 * d + 8 * g4 + 4 * hi;
                            const f32x4 w4 = w4s[d][g4];
                            u32x2 w; w.x = pk_bf16(o[d][4 * g4] * rn * w4.x, o[d][4 * g4 + 1] * rn * w4.y); w.y = pk_bf16(o[d][4 * g4 + 2] * rn * w4.z, o[d][4 * g4 + 3] * rn * w4.w);
                            *(u32x2*)(orow + dd) = w;
                        }
                }
            }
            __syncthreads();
#undef ATT_DMA_K
#undef ATT_DMA_V
#undef ATT_QK
#undef ATT_PV
        }
    }
}

constexpr int GP_PITCH = 520;
__device__ __forceinline__ void gla_prep(LAS unsigned char* lds, const bf16_t* QK, const float* gz, const float* Wg, const float* bias,
                                         bf16_t* QPimg, bf16_t* KTimg, bf16_t* Aimg, float* dec, int G) {
    const int tid = opaque_tid(), lane = tid & 63, wid = __builtin_amdgcn_readfirstlane(tid >> 6), l31 = lane & 31, hi = lane >> 5;
    LAS float* gzs = (LAS float*)lds;
    LAS bf16_t* Qs = (LAS bf16_t*)(lds + 4096);
    LAS bf16_t* Ks = (LAS bf16_t*)(lds + 4096 + 64 * GP_PITCH * 2);
    const int hh = tid >> 7, dk = tid & 127;
    float wg[16];
#pragma unroll
    for (int r = 0; r < 16; ++r) wg[r] = Wg[r * 512 + tid];
    const float bi = bias[tid];
    for (int u = blockIdx.x; u < 513; u += G) {
        const int m0 = (u < 512) ? (u >> 6) * SEQ + (u & 63) * 64 : MR; const int ntok = (u < 512) ? 64 : 16;
        u32x4 raw[16];
#pragma unroll
        for (int i = 0; i < 16; ++i) { const int row = 4 * i + (tid >> 7); raw[i] = (u32x4){0u, 0u, 0u, 0u}; if (row < ntok) raw[i] = *(const u32x4*)(QK + (size_t)(m0 + row) * 1024 + (tid & 127) * 8); }
        if (tid < 256) { const int t = tid >> 2, q4 = tid & 3; f32x4 v = {0.f, 0.f, 0.f, 0.f}; if (t < ntok) v = *(const f32x4*)(gz + (size_t)(m0 + t) * 16 + q4 * 4); *(LAS f32x4*)(gzs + t * 16 + q4 * 4) = v; }
        { LAS bf16_t* dstb = (tid & 64) ? Ks : Qs; const int colb = ((tid & 127) * 8) & 511;
#pragma unroll
          for (int i = 0; i < 16; ++i) *(LAS u32x4*)(dstb + (4 * i + (tid >> 7)) * GP_PITCH + colb) = raw[i]; }
        __syncthreads();
        float bb[64]; float bs = 0.f;
#pragma unroll
        for (int t = 0; t < 64; ++t) {
            float x = bi;
#pragma unroll
            for (int q4 = 0; q4 < 4; ++q4) { const f32x4 g4 = *(const LAS f32x4*)(gzs + t * 16 + q4 * 4); x += g4.x * wg[4 * q4] + g4.y * wg[4 * q4 + 1] + g4.z * wg[4 * q4 + 2] + g4.w * wg[4 * q4 + 3]; }
            float ls = (fminf(x, 0.f) - __logf(1.f + __expf(-fabsf(x)))) * (1.f / 16.f);
            if (t >= ntok) ls = 0.f;
            bs += ls; bb[t] = bs;
        }
        const float blast = bs;
#pragma unroll
        for (int t8 = 0; t8 < 8; ++t8) {
            float kh[8];
#pragma unroll
            for (int tt = 0; tt < 8; ++tt) { const int t = t8 * 8 + tt;
                const float qv = bf2f(Qs[t * GP_PITCH + tid]), kv = bf2f(Ks[t * GP_PITCH + tid]);
                Qs[t * GP_PITCH + tid] = f2bf(qv * __expf(bb[t]) * 0.08838834764831845f);
                Ks[t * GP_PITCH + tid] = f2bf(kv * __expf(-bb[t]));
                kh[tt] = kv * __expf(blast - bb[t]); }
            u32x4 w; w.x = pk_bf16(kh[0], kh[1]); w.y = pk_bf16(kh[2], kh[3]); w.z = pk_bf16(kh[4], kh[5]); w.w = pk_bf16(kh[6], kh[7]);
            *(u32x4*)(KTimg + ((((size_t)u * 4 + hh) * 8 + t8) * 128 + dk) * 8) = w;
        }
        dec[((size_t)u * 4 + hh) * 256 + dk] = __expf(blast);
        __syncthreads();
#pragma unroll
        for (int i = 0; i < 8; ++i) { const int it = tid + 512 * i, t = it & 63, ch = (it >> 6) & 15, h2 = it >> 10; const int dkb = 32 * (ch >> 2) + 16 * ((ch >> 1) & 1) + 4 * (ch & 1);
            const u32x2 a = *(const LAS u32x2*)(Qs + t * GP_PITCH + h2 * 128 + dkb), b2 = *(const LAS u32x2*)(Qs + t * GP_PITCH + h2 * 128 + dkb + 8);
            *(u32x4*)(QPimg + ((((size_t)u * 4 + h2) * 16 + ch) * 64 + t) * 8) = (u32x4){a.x, a.y, b2.x, b2.y}; }
        { const int h2 = wid >> 1, tt = wid & 1; const int t = 32 * tt + l31;
#pragma unroll
          for (int jt = 0; jt < 2; ++jt) {
            f32x16 acc;
#pragma unroll
            for (int r = 0; r < 16; ++r) acc[r] = 0.f;
#pragma unroll
            for (int ks = 0; ks < 8; ++ks) {
                const bf16x8 af = *(const LAS bf16x8*)(Ks + (32 * jt + l31) * GP_PITCH + h2 * 128 + 16 * ks + 8 * hi);
                const bf16x8 bf = *(const LAS bf16x8*)(Qs + t * GP_PITCH + h2 * 128 + 16 * ks + 8 * hi);
                acc = __builtin_amdgcn_mfma_f32_32x32x16_bf16(af, bf, acc, 0, 0, 0);
            }
#pragma unroll
            for (int g4 = 0; g4 < 4; ++g4) { float v[4];
#pragma unroll
                for (int e = 0; e < 4; ++e) { const int jj = 32 * jt + 8 * g4 + 4 * hi + e; v[e] = (jj <= t) ? acc[4 * g4 + e] : 0.f; }
                u32x2 w; w.x = pk_bf16(v[0], v[1]); w.y = pk_bf16(v[2], v[3]);
                *(u32x2*)(Aimg + ((((size_t)u * 4 + h2) * 8 + (4 * jt + g4)) * 64 + t) * 8 + 4 * hi) = w; }
          } }
        __syncthreads();
    }
}

constexpr int GS_QP = 0, GS_KT = 16384, GS_A = 32768, GS_VT = 40960, GS_DEC = 49152, GS_STAGE = 50176, GS_NPIECE = 49;
static_assert(3 * GS_STAGE <= 153600, "scan ring fits below the barrier words");
__device__ __forceinline__ void gla_scan(LAS unsigned char* lds, const bf16_t* QPimg, const bf16_t* KTimg, const bf16_t* Aimg, const bf16_t* VTimg, const bf16_t* VTmeta,
                                         const float* dec, bf16_t* Oraw) {
    if (blockIdx.x >= 128) return;
    const int tid = opaque_tid(), lane = tid & 63, wid = __builtin_amdgcn_readfirstlane(tid >> 6), l31 = lane & 31, hi = lane >> 5;
    const int bh = blockIdx.x & 31, quarter = blockIdx.x >> 5, b = bh >> 2, h = bh & 3;
    const bool worker = wid < 2;
    const int w8 = quarter * 2 + wid;
    const unsigned ldsb = (unsigned)(uintptr_t)lds;
#define GS_ISSUE(cc, slot) do { const size_t iu_ = ((cc) == 0) ? 512 : (size_t)b * 64 + (cc) - 1; const size_t ih_ = iu_ * 4 + h; \
        const char* vsrc_ = (const char*)(((cc) == 0) ? VTmeta + (size_t)h * 16384 : VTimg + ((size_t)(b * 4 + h) * 64 + (cc) - 1) * 16384); \
        for (int p_ = wid - 2; p_ < GS_NPIECE; p_ += 6) { const char* src_; \
            if (p_ < 16) src_ = (const char*)(QPimg + ih_ * 8192) + p_ * 1024; \
            else if (p_ < 32) src_ = (const char*)(KTimg + ih_ * 8192) + (p_ - 16) * 1024; \
            else if (p_ < 40) src_ = (const char*)(Aimg + ih_ * 4096) + (p_ - 32) * 1024; \
            else if (p_ < 48) src_ = vsrc_ + ((p_ - 40) * 256 + quarter * 64) * 16; \
            else src_ = (const char*)(dec + ih_ * 256); \
            glds16(src_ + lane * 16, (unsigned)__builtin_amdgcn_readfirstlane(ldsb + (slot) * GS_STAGE + p_ * 1024)); } } while (0)
    f32x16 S[4];
#pragma unroll
    for (int T = 0; T < 4; ++T)
#pragma unroll
        for (int r = 0; r < 16; ++r) S[T][r] = 0.f;
    if (!worker) { GS_ISSUE(0, 0); GS_ISSUE(1, 1); }
    WAITV_BAR(0);
    int slot = 0;
    for (int cc = 0; cc <= 64; ++cc) {
        if (!worker) {
            if (cc + 2 <= 64) { const int s2 = slot == 0 ? 2 : slot - 1; GS_ISSUE(cc + 2, s2); }
        } else {
            const LAS unsigned char* st = lds + slot * GS_STAGE;
#define GA(tt, s4) (*(const LAS bf16x8*)(st + GS_A + ((2 * (s4) + hi) * 64 + 32 * (tt) + l31) * 16))
#define GQ(tt, p) (*(const LAS bf16x8*)(st + GS_QP + ((((p) >> 1) * 4 + ((p) & 1) * 2 + hi) * 64 + 32 * (tt) + l31) * 16))
#define GK(s4, T) (*(const LAS bf16x8*)(st + GS_KT + ((2 * (s4) + hi) * 128 + 32 * (T) + l31) * 16))
#define RD_A(F, k) do { F[0] = GA(0, 2 * (k)); F[1] = GA(1, 2 * (k)); F[2] = GA(0, 2 * (k) + 1); F[3] = GA(1, 2 * (k) + 1); } while (0)
#define MM_A(F, k) do { acc0 = __builtin_amdgcn_mfma_f32_32x32x16_bf16(vf[2 * (k)], F[0], acc0, 0, 0, 0); acc1 = __builtin_amdgcn_mfma_f32_32x32x16_bf16(vf[2 * (k)], F[1], acc1, 0, 0, 0); \
                        acc0 = __builtin_amdgcn_mfma_f32_32x32x16_bf16(vf[2 * (k) + 1], F[2], acc0, 0, 0, 0); acc1 = __builtin_amdgcn_mfma_f32_32x32x16_bf16(vf[2 * (k) + 1], F[3], acc1, 0, 0, 0); } while (0)
#define RD_Q(F, k) do { F[0] = GQ(0, 2 * (k)); F[1] = GQ(1, 2 * (k)); F[2] = GQ(0, 2 * (k) + 1); F[3] = GQ(1, 2 * (k) + 1); } while (0)
#define MM_Q(F, k) do { acc0 = __builtin_amdgcn_mfma_f32_32x32x16_bf16(sb[k][0], F[0], acc0, 0, 0, 0); acc1 = __builtin_amdgcn_mfma_f32_32x32x16_bf16(sb[k][0], F[1], acc1, 0, 0, 0); \
                        acc0 = __builtin_amdgcn_mfma_f32_32x32x16_bf16(sb[k][1], F[2], acc0, 0, 0, 0); acc1 = __builtin_amdgcn_mfma_f32_32x32x16_bf16(sb[k][1], F[3], acc1, 0, 0, 0); } while (0)
#define RD_K(F, s4) do { F[0] = GK(s4, 0); F[1] = GK(s4, 1); F[2] = GK(s4, 2); F[3] = GK(s4, 3); } while (0)
#define MM_K(F, s4) do { _Pragma("unroll") for (int T = 0; T < 4; ++T) S[T] = __builtin_amdgcn_mfma_f32_32x32x16_bf16(F[T], vf[s4], S[T], 0, 0, 0); } while (0)
#define SBAR __builtin_amdgcn_sched_barrier(0)
            bf16x8 vf[4], fa[4], fb[4];
#pragma unroll
            for (int s4 = 0; s4 < 4; ++s4) vf[s4] = *(const LAS bf16x8*)(st + GS_VT + ((2 * s4 + hi) * 64 + 32 * wid + l31) * 16);
            RD_A(fa, 0); SBAR; RD_A(fb, 1);
            bf16x8 sb[4][2];
#pragma unroll
            for (int T = 0; T < 4; ++T)
#pragma unroll
                for (int s2 = 0; s2 < 2; ++s2) { u32x4 w;
#pragma unroll
                    for (int q4 = 0; q4 < 4; ++q4) w[q4] = pk_bf16(S[T][8 * s2 + 2 * q4], S[T][8 * s2 + 2 * q4 + 1]);
                    sb[T][s2] = __builtin_bit_cast(bf16x8, w); }
            f32x16 acc0, acc1;
#pragma unroll
            for (int r = 0; r < 16; ++r) { acc0[r] = 0.f; acc1[r] = 0.f; }
            SBAR; MM_A(fa, 0); SBAR; RD_Q(fa, 0); SBAR; MM_A(fb, 1); SBAR; RD_Q(fb, 1); SBAR; MM_Q(fa, 0); SBAR; RD_Q(fa, 2); SBAR; MM_Q(fb, 1); SBAR; RD_Q(fb, 3); SBAR; MM_Q(fa, 2); SBAR; RD_K(fa, 0); SBAR; MM_Q(fb, 3);
            if (cc > 0 || b == 0) {
                bf16_t* ob = Oraw + (((cc == 0) ? (size_t)512 : (size_t)b * 64 + cc - 1) * 4 + h) * 16384 + (size_t)(w8 * 8) * 256 + lane * 4;
#pragma unroll
                for (int g4 = 0; g4 < 4; ++g4) { u32x2 w; w.x = pk_bf16(acc0[4 * g4], acc0[4 * g4 + 1]); w.y = pk_bf16(acc0[4 * g4 + 2], acc0[4 * g4 + 3]); *(u32x2*)(ob + g4 * 256) = w; }
#pragma unroll
                for (int g4 = 0; g4 < 4; ++g4) { u32x2 w; w.x = pk_bf16(acc1[4 * g4], acc1[4 * g4 + 1]); w.y = pk_bf16(acc1[4 * g4 + 2], acc1[4 * g4 + 3]); *(u32x2*)(ob + (4 + g4) * 256) = w; }
            }
#pragma unroll
            for (int T = 0; T < 4; ++T)
#pragma unroll
                for (int g4 = 0; g4 < 4; ++g4) { const f32x4 d4 = *(const LAS f32x4*)(st + GS_DEC + (32 * T + 8 * g4 + 4 * hi) * 4);
                    S[T][4 * g4] *= d4.x; S[T][4 * g4 + 1] *= d4.y; S[T][4 * g4 + 2] *= d4.z; S[T][4 * g4 + 3] *= d4.w; }
            SBAR; RD_K(fb, 1); SBAR; MM_K(fa, 0); SBAR; RD_K(fa, 2); SBAR; MM_K(fb, 1); SBAR; RD_K(fb, 3); SBAR; MM_K(fa, 2); SBAR; MM_K(fb, 3);
#undef GA
#undef GQ
#undef GK
#undef RD_A
#undef MM_A
#undef RD_Q
#undef MM_Q
#undef RD_K
#undef MM_K
#undef SBAR
        }
        if (worker) { asm volatile("s_waitcnt lgkmcnt(0)\n\ts_barrier" ::: "memory"); }
        else if (cc + 2 > 64) { WAITV_BAR(0); }
        else if (wid == 2) { WAITV_BAR(9); }
        else { WAITV_BAR(8); }
        slot = slot == 2 ? 0 : slot + 1;
    }
#undef GS_ISSUE
}

__device__ __forceinline__ void gla_finalize(LAS unsigned char* lds, const bf16_t* Oraw, const bf16_t* Gb, const float* normw, bf16_t* Oout, int G) {
    const int tid = opaque_tid(), lane = tid & 63, wid = __builtin_amdgcn_readfirstlane(tid >> 6);
    constexpr int FP = 264;
    LAS bf16_t* tile = (LAS bf16_t*)lds;
    const f32x4 nw = *(const f32x4*)(normw + 4 * lane);
    for (int u = blockIdx.x; u < 513 * 4; u += G) {
        const int iu = u >> 2, h = u & 3;
        const bf16_t* img = Oraw + (size_t)u * 16384;
        const int ntok = iu < 512 ? 64 : 16; const int m0 = iu < 512 ? (iu >> 6) * SEQ + (iu & 63) * 64 : MR;
        u32x2 iv[8], gg[8];
#pragma unroll
        for (int i = 0; i < 8; ++i) iv[i] = *(const u32x2*)(img + ((size_t)(wid + 8 * i) * 64 + lane) * 4);
#pragma unroll
        for (int i = 0; i < 8; ++i) { const int t = wid * 8 + i; gg[i] = *(const u32x2*)(Gb + (size_t)(m0 + (t < ntok ? t : 0)) * 1024 + h * 256 + 4 * lane); }
#pragma unroll
        for (int i = 0; i < 8; ++i) { const int combo = wid + 8 * i, g4 = combo & 3, tt = (combo >> 2) & 1, w = combo >> 3;
            const int t = 32 * tt + (lane & 31), dv = 32 * w + 8 * g4 + 4 * (lane >> 5);
            *(LAS u32x2*)(tile + t * FP + dv) = iv[i]; }
        __syncthreads();
        float o[8][4], sq[8];
#pragma unroll
        for (int i = 0; i < 8; ++i) { const u32x2 v = *(const LAS u32x2*)(tile + (wid * 8 + i) * FP + 4 * lane);
            o[i][0] = __uint_as_float(v.x << 16); o[i][1] = __uint_as_float(v.x & 0xffff0000u); o[i][2] = __uint_as_float(v.y << 16); o[i][3] = __uint_as_float(v.y & 0xffff0000u);
            sq[i] = (o[i][0] * o[i][0] + o[i][1] * o[i][1]) + (o[i][2] * o[i][2] + o[i][3] * o[i][3]); }
#pragma unroll
        for (int st = 1; st < 64; st <<= 1)
#pragma unroll
            for (int i = 0; i < 8; ++i) sq[i] += __shfl_xor(sq[i], st);
#pragma unroll
        for (int i = 0; i < 8; ++i) { const int t = wid * 8 + i;
            const float rinv = rsqrtf(sq[i] * (1.f / 256.f) + EPS);
            const float g0 = __uint_as_float(gg[i].x << 16), g1 = __uint_as_float(gg[i].x & 0xffff0000u), g2 = __uint_as_float(gg[i].y << 16), g3 = __uint_as_float(gg[i].y & 0xffff0000u);
            u32x2 w; w.x = pk_bf16(o[i][0] * rinv * nw.x * (g0 / (1.f + __expf(-g0))), o[i][1] * rinv * nw.y * (g1 / (1.f + __expf(-g1))));
            w.y = pk_bf16(o[i][2] * rinv * nw.z * (g2 / (1.f + __expf(-g2))), o[i][3] * rinv * nw.w * (g3 / (1.f + __expf(-g3))));
            if (t < ntok) *(u32x2*)(Oout + (size_t)(m0 + t) * 1024 + h * 256 + 4 * lane) = w; }
        __syncthreads();
    }
}

struct Args { Ptrs p; };


#define XB_TMO      128
#define XB_XCNT(j)  (256  + 64 * (j))
#define XB_XSUB(j)  (1280 + 64 * (j))
#define XB_XGEN(j)  (2304 + 64 * (j))
#define XB_TOP      3328
#define XB_TOPGEN   3392
#define XCD_BAR_WORDS 3456
#define XB_SPIN_CAP (1u << 18)

__device__ __forceinline__ unsigned xb_ld(unsigned* p)              { return __hip_atomic_load(p, __ATOMIC_RELAXED, __HIP_MEMORY_SCOPE_AGENT); }
__device__ __forceinline__ unsigned xb_add(unsigned* p, unsigned v) { return __hip_atomic_fetch_add(p, v, __ATOMIC_RELAXED, __HIP_MEMORY_SCOPE_AGENT); }
__device__ __forceinline__ unsigned xb_xcc_id() { return (unsigned)__builtin_amdgcn_s_getreg((3 << 11) | 20) & 0xFu; }
#define XB_SPIN(cond, bar) do { unsigned _sp = 0; while (cond) { __builtin_amdgcn_s_sleep(1); \
    if ((++_sp & 255u) == 0u) { if (xb_ld(&(bar)[XB_TMO])) break; if (_sp > XB_SPIN_CAP) { atomicAdd(&(bar)[XB_TMO], 1u); break; } } } } while (0)

struct XcdBarrier {
    unsigned* bar; unsigned x;
    volatile LAS unsigned* st;
};

__device__ __forceinline__ XcdBarrier xcd_barrier_post(unsigned* bar, volatile LAS unsigned* st) {
    XcdBarrier b; b.bar = bar; b.x = xb_xcc_id(); b.st = st;
    if (threadIdx.x == 0) (void)xb_add(&bar[XB_XCNT(b.x)], 1u);
    return b;
}
__device__ __forceinline__ void xcd_barrier_complete(unsigned* bar, unsigned x, unsigned& nloc, unsigned& nx) {
    const unsigned G = gridDim.x * gridDim.y * gridDim.z;
    unsigned sum, cnt, mine, sp = 0u;
    for (;;) {
        sum = 0u; cnt = 0u; mine = 0u;
#pragma unroll
        for (unsigned j = 0; j < 16; ++j) { const unsigned c = xb_ld(&bar[XB_XCNT(j)]); sum += c; cnt += (c > 0u) ? 1u : 0u; mine = (j == x) ? c : mine; }
        if (sum == G) break;
        __builtin_amdgcn_s_sleep(1);
        if ((++sp & 255u) == 0u) { if (xb_ld(&bar[XB_TMO])) break; if (sp > XB_SPIN_CAP) { atomicAdd(&bar[XB_TMO], 1u); break; } }
    }
    nloc = mine > 0u ? mine : 1u; nx = cnt > 0u ? cnt : 1u;
}

__device__ __forceinline__ void xcd_barrier(const XcdBarrier& b) {
    asm volatile("s_waitcnt vmcnt(0)" ::: "memory");
    __syncthreads();
    if (threadIdx.x == 0) {
        unsigned* bar = b.bar;
        __builtin_amdgcn_s_waitcnt(0);
        unsigned nloc = b.st[0], nx = b.st[1];
        if (nloc == 0u) { xcd_barrier_complete(bar, b.x, nloc, nx); b.st[0] = nloc; b.st[1] = nx; }
        const unsigned old = xb_add(&bar[XB_XSUB(b.x)], 1u);
        const unsigned gen = old / nloc;
        if (old + 1u == (gen + 1u) * nloc) {
            __builtin_amdgcn_fence(__ATOMIC_RELEASE, "agent");
            asm volatile("s_waitcnt vmcnt(0)" ::: "memory");
            const unsigned og = xb_add(&bar[XB_TOP], 1u);
            const unsigned tg = og / nx;
            if (og + 1u == (tg + 1u) * nx) xb_add(&bar[XB_TOPGEN], 1u);
            else XB_SPIN(xb_ld(&bar[XB_TOPGEN]) == tg, bar);
            __builtin_amdgcn_fence(__ATOMIC_ACQUIRE, "agent");
            xb_add(&bar[XB_XGEN(b.x)], 1u);
            asm volatile("s_waitcnt vmcnt(0)" ::: "memory");
        } else {
            XB_SPIN(xb_ld(&bar[XB_XGEN(b.x)]) == gen, bar);
            __builtin_amdgcn_fence(__ATOMIC_ACQUIRE, "agent");
            asm volatile("s_waitcnt vmcnt(0)" ::: "memory");
        }
    }
    __syncthreads();
}

#define KARGS() ({ KP k_ = (KP)__builtin_amdgcn_kernarg_segment_ptr(); asm volatile("" : "+s"(k_)); k_; })
#define PHASE_BEGIN KP P = KARGS(); unsigned char* const ws = P->ws; const int G = gridDim.x; float* const hreal = P->out; float* const hmeta = (float*)(ws + WS_HMETA); bf16_t* const HN = (bf16_t*)(ws + WS_HN); (void)hreal; (void)hmeta; (void)HN; (void)G;

__global__ void __launch_bounds__(NTHR, 2) hybrid_fwd(Args args) {
    extern __shared__ __attribute__((aligned(16))) unsigned char lds_raw[];
    LAS unsigned char* lds = (LAS unsigned char*)lds_raw;
    cg::grid_group grid = cg::this_grid();
    if (threadIdx.x < 64) ((LAS unsigned*)(lds + LDS_BAR_OFF))[threadIdx.x] = 0u;
    __syncthreads();
    { KP Pb = KARGS(); (void)xcd_barrier_post((unsigned*)(Pb->ws + WS_CTL), (volatile LAS unsigned*)(lds + LDS_BAR_OFF)); }
#define GSYNC() do { KP Pb_ = KARGS(); XcdBarrier b_; b_.bar = (unsigned*)(Pb_->ws + WS_CTL); b_.x = xb_xcc_id(); b_.st = (volatile LAS unsigned*)(lds + LDS_BAR_OFF); xcd_barrier(b_); } while (0)

    { KP P0 = KARGS(); p0_prologue(P0, lds, gridDim.x); }

    for (int layer = 0; layer < 4; ++layer) {
        asm volatile("" : "+s"(layer));
        const int j = layer >> 1;
        {   PHASE_BEGIN
            const int gt = blockIdx.x * NTHR + opaque_tid(), NGT = G * NTHR;
            u32x4* z = (u32x4*)(ws + ((layer & 1) ? GB_VTMETA : AB_KMETA)); const int nz = ((layer & 1) ? 131072 : 262144) / 16;
            for (int e = gt; e < nz; e += NGT) z[e] = (u32x4){0u, 0u, 0u, 0u};
            norm_phase(layer == 0 ? P->x : hreal, layer == 0 ? P->meta : hmeta, P->mix_w + layer * DM, HN, G);
        }
        if (layer == 0) grid.sync(); else GSYNC();
        if ((layer & 1) == 0) {
            {   PHASE_BEGIN
                const bf16_t* Wqkv = (const bf16_t*)(ws + WS_WQKV + j * WS_WQKV_STRIDE);
                bf16_t* Qb = (bf16_t*)(ws + AB_Q); bf16_t* Kimg = (bf16_t*)(ws + AB_KIMG);
                pg8::Gemm g{HN, Wqkv, MR, 2048, DM}; pg8::StaticOrder S; S.init(MR, 2048, G, (int)blockIdx.x);
                pg8::EpiB E{pg8::EM_ATT_QK, Qb, Kimg, QSCALE};
                pg8::gemm_phase<pg8::EpiB, pg8::StaticOrder, true, true>(lds, g, S, E); }
            {   PHASE_BEGIN
                const bf16_t* Wqkv = (const bf16_t*)(ws + WS_WQKV + j * WS_WQKV_STRIDE); bf16_t* Vimg = (bf16_t*)(ws + AB_VIMG);
                pg8::Gemm g{Wqkv + (size_t)2048 * DM, HN, 1024, MR, DM}; pg8::StaticOrder S; S.init(1024, MR, G, (int)blockIdx.x);
                pg8::EpiB E{pg8::EM_ATT_VT, Vimg, nullptr, 1.f};
                pg8::gemm_phase<pg8::EpiB, pg8::StaticOrder, true, true>(lds, g, S, E); }
            {   PHASE_BEGIN
                const bf16_t* Wqkv = (const bf16_t*)(ws + WS_WQKV + j * WS_WQKV_STRIDE);
                MiniEpi ME{MM_ATT, ws + AB_Q, ws + AB_KMETA, ws + AB_VMETA, nullptr}; mini_gemm(lds, HN + (size_t)MR * DM, Wqkv, 3072, DM, ME, G); }
            GSYNC();
#ifndef SKIP_ATT
            {   PHASE_BEGIN
                attn_phase(lds, (const bf16_t*)(ws + AB_Q), (const bf16_t*)(ws + AB_KIMG), (const bf16_t*)(ws + AB_VIMG), (const bf16_t*)(ws + AB_KMETA), (const bf16_t*)(ws + AB_VMETA),
                           HN, P->attn_lam + j * 256, P->attn_subln + j * 128, layer == 0 ? 0.2f : 0.47071301834303590f, G); }
#endif
            GSYNC();
            {   PHASE_BEGIN
                const bf16_t* Wo = (const bf16_t*)(ws + WS_WAO + j * WS_WAO_STRIDE);
                pg8::Gemm g{HN, Wo, MR, DM, DM}; pg8::StaticOrder S; S.init(MR, DM, G, (int)blockIdx.x);
                pg8::EpiRes E{layer == 0 ? P->x : hreal, hreal};
                pg8::gemm_phase<pg8::EpiRes, pg8::StaticOrder, true, true>(lds, g, S, E); }
            {   PHASE_BEGIN
                const bf16_t* Wo = (const bf16_t*)(ws + WS_WAO + j * WS_WAO_STRIDE);
                MiniEpi ME{MM_RES, hmeta, nullptr, nullptr, layer == 0 ? P->meta : hmeta}; mini_gemm(lds, HN + (size_t)MR * DM, Wo, DM, DM, ME, G); }
            GSYNC();
        } else {
            {   PHASE_BEGIN
                const bf16_t* Wg = (const bf16_t*)(ws + WS_WGLA + j * WS_WGLA_STRIDE);
                pg8::Gemm g{HN, Wg, MR, 2048, DM}; pg8::StaticOrder S; S.init(MR, 2048, G, (int)blockIdx.x);
                pg8::EpiB E{pg8::EM_GLA_QKG, (bf16_t*)(ws + GB_QK), (bf16_t*)(ws + GB_G), 1.f};
                pg8::gemm_phase<pg8::EpiB, pg8::StaticOrder, true, true>(lds, g, S, E); }
            {   PHASE_BEGIN
                const bf16_t* Wg = (const bf16_t*)(ws + WS_WGLA + j * WS_WGLA_STRIDE);
                pg8::Gemm g{Wg + (size_t)2048 * DM, HN, 1024, MR, DM}; pg8::StaticOrder S; S.init(1024, MR, G, (int)blockIdx.x);
                pg8::EpiB E{pg8::EM_GLA_VT, (bf16_t*)(ws + GB_VT), nullptr, 1.f};
                pg8::gemm_phase<pg8::EpiB, pg8::StaticOrder, true, true>(lds, g, S, E); }
            {   PHASE_BEGIN
                const bf16_t* Wg = (const bf16_t*)(ws + WS_WGLA + j * WS_WGLA_STRIDE);
                MiniEpi ME{MM_GLA, ws + GB_QK, ws + GB_G, ws + GB_VTMETA, nullptr}; mini_gemm(lds, HN + (size_t)MR * DM, Wg, 3072, DM, ME, G); }
            {   PHASE_BEGIN
                const bf16_t* Wg = (const bf16_t*)(ws + WS_WGLA + j * WS_WGLA_STRIDE);
                gz_gemm(Wg + (size_t)3072 * DM, HN, (float*)(ws + GB_GZ), G); }
            GSYNC();
#ifndef SKIP_PREP
            {   PHASE_BEGIN
                gla_prep(lds, (const bf16_t*)(ws + GB_QK), (const float*)(ws + GB_GZ), P->gla_w_gate + j * 16 * 512, P->gla_bias + j * 512,
                         (bf16_t*)(ws + GB_QP), (bf16_t*)(ws + GB_KT), (bf16_t*)(ws + GB_A), (float*)(ws + GB_DEC), G); }
#endif
            GSYNC();
#ifndef SKIP_SCAN
            {   PHASE_BEGIN
                gla_scan(lds, (const bf16_t*)(ws + GB_QP), (const bf16_t*)(ws + GB_KT), (const bf16_t*)(ws + GB_A), (const bf16_t*)(ws + GB_VT), (const bf16_t*)(ws + GB_VTMETA),
                         (const float*)(ws + GB_DEC), (bf16_t*)(ws + GB_ORAW)); }
#endif
            GSYNC();
            {   PHASE_BEGIN
                gla_finalize(lds, (const bf16_t*)(ws + GB_ORAW), (const bf16_t*)(ws + GB_G), P->gla_norm + j * 256, HN, G); }
            GSYNC();
            {   PHASE_BEGIN
                const bf16_t* Wo = (const bf16_t*)(ws + WS_WGO + j * WS_WGO_STRIDE);
                pg8::Gemm g{HN, Wo, MR, DM, DM}; pg8::StaticOrder S; S.init(MR, DM, G, (int)blockIdx.x);
                pg8::EpiRes E{hreal, hreal};
                pg8::gemm_phase<pg8::EpiRes, pg8::StaticOrder, true, true>(lds, g, S, E); }
            {   PHASE_BEGIN
                const bf16_t* Wo = (const bf16_t*)(ws + WS_WGO + j * WS_WGO_STRIDE);
                MiniEpi ME{MM_RES, hmeta, nullptr, nullptr, hmeta}; mini_gemm(lds, HN + (size_t)MR * DM, Wo, DM, DM, ME, G); }
            GSYNC();
        }
        {   PHASE_BEGIN
            norm_phase(hreal, hmeta, P->mlp_norm + layer * DM, HN, G); }
        GSYNC();
        {   PHASE_BEGIN
            const bf16_t* Wu = (const bf16_t*)(ws + WS_WUP + layer * WS_WUP_STRIDE); bf16_t* U = (bf16_t*)(ws + MB_U);
            pg8::Gemm g{HN, Wu, MR, FF, DM}; pg8::StaticOrder S; S.init(MR, FF, G, (int)blockIdx.x);
            pg8::EpiB E{pg8::EM_RELU2, U, nullptr, 1.f};
            pg8::gemm_phase<pg8::EpiB, pg8::StaticOrder, true, true>(lds, g, S, E); }
        {   PHASE_BEGIN
            const bf16_t* Wu = (const bf16_t*)(ws + WS_WUP + layer * WS_WUP_STRIDE);
            MiniEpi ME{MM_RELU2, ws + MB_U, nullptr, nullptr, nullptr}; mini_gemm(lds, HN + (size_t)MR * DM, Wu, FF, DM, ME, G); }
        GSYNC();
        {   PHASE_BEGIN
            const bf16_t* Wd = (const bf16_t*)(ws + WS_WDN + layer * WS_WDN_STRIDE); const bf16_t* U = (const bf16_t*)(ws + MB_U);
            pg8::Gemm g{U, Wd, MR, DM, FF}; pg8::StaticOrder S; S.init(MR, DM, G, (int)blockIdx.x);
            pg8::EpiRes E{hreal, hreal};
            pg8::gemm_phase<pg8::EpiRes, pg8::StaticOrder, true, true>(lds, g, S, E); }
        {   PHASE_BEGIN
            const bf16_t* Wd = (const bf16_t*)(ws + WS_WDN + layer * WS_WDN_STRIDE); const bf16_t* U = (const bf16_t*)(ws + MB_U);
            MiniEpi ME{MM_RES, hmeta, nullptr, nullptr, hmeta}; mini_gemm(lds, U + (size_t)MR * FF, Wd, DM, FF, ME, G); }
        GSYNC();
    }
    {   PHASE_BEGIN
        final_norm_phase(hreal, P->final_w, G); }
}

extern "C" void kernel_launch(void* const* d_in, const int* in_sizes, int n_in, void* d_out, int out_size, void* d_ws, size_t ws_size, hipStream_t stream) {
    static int grid = 0;
    if (grid == 0) {
        if (n_in != 16 || out_size != MR * DM || ws_size < WS_END) { fprintf(stderr, "kernel_launch: unexpected shapes (n_in %d out %d ws %zu need %zu)\n", n_in, out_size, ws_size, (size_t)WS_END); grid = -1; return; }
        int dev = 0, cus = 0, per_cu = 0;
        hipGetDevice(&dev);
        hipDeviceGetAttribute(&cus, hipDeviceAttributeMultiprocessorCount, dev);
        hipFuncSetAttribute((const void*)hybrid_fwd, hipFuncAttributeMaxDynamicSharedMemorySize, LDS_BYTES);
        hipOccupancyMaxActiveBlocksPerMultiprocessor(&per_cu, (const void*)hybrid_fwd, NTHR, LDS_BYTES);
        if (per_cu < 1) { fprintf(stderr, "kernel_launch: occupancy query says %d blocks per CU\n", per_cu); per_cu = 1; }
        grid = cus;
        (void)hipGetLastError();
    }
    if (grid < 0) return;
    if (hipMemsetAsync((char*)d_ws + WS_CTL, 0, 16384, stream) != hipSuccess) { fprintf(stderr, "kernel_launch: memset of the barrier words failed\n"); return; }
    Args a{};
    const float** pp = (const float**)&a.p;
    for (int i = 0; i < 16; ++i) pp[i] = (const float*)d_in[i];
    a.p.out = (float*)d_out; a.p.ws = (unsigned char*)d_ws;
    void* kargs[] = {&a};
    hipError_t e = hipLaunchCooperativeKernel((const void*)hybrid_fwd, dim3(grid), dim3(NTHR), kargs, LDS_BYTES, stream);
    if (e != hipSuccess) fprintf(stderr, "cooperative launch failed: %s (grid %d)\n", hipGetErrorString(e), grid);
}
```
